# Optimizing an MI355X kernel written in HIP

```python
import jax, jax.numpy as jnp
from jax import lax
import numpy as np

D_MODEL = 1024
BATCH = 8
SEQ = 2048
DEPTH = 1
DEC_BATCH = 128
DEC_SEQ = 8
PAST_LEN = 16384
PAGE_SIZE = 128

D_MIX = D_MODEL
D_A = D_MIX // 2
D_B = D_MIX - D_A
HEAD_A = 128
H_A = D_A // HEAD_A
DK = HEAD_A
DV = HEAD_A
HEAD_B = 128
H_B = D_B // HEAD_B
CHUNK_A = 64
CHUNK_B = 128
D_IN = 4 * D_A + 3 * D_B
EPS = 1e-6

kernel_name = "hymba_hgrn2_chunkmlp_step"


def _rms_norm(x, g):
    xf = x.astype(jnp.float32)
    y = xf * lax.rsqrt(jnp.mean(xf * xf, axis=-1, keepdims=True) + EPS)
    return (y * g.astype(jnp.float32)).astype(x.dtype)


def _layer_norm(x, g, b):
    xf = x.astype(jnp.float32)
    mu = jnp.mean(xf, axis=-1, keepdims=True)
    var = jnp.mean(jnp.square(xf - mu), axis=-1, keepdims=True)
    y = (xf - mu) * lax.rsqrt(var + EPS)
    return (y * g.astype(jnp.float32) + b.astype(jnp.float32)).astype(x.dtype)


def _hgrn2_chunked(q, logf, k, v, s0):
    B, L, H, _ = q.shape
    C = min(CHUNK_A, L)
    n_chunks = -(-L // C)
    pad = n_chunks * C - L

    def to_chunks(a):
        a = jnp.pad(a, ((0, 0), (0, pad), (0, 0), (0, 0)))
        return a.reshape(B, n_chunks, C, H, a.shape[-1]).transpose(1, 0, 2, 3, 4)

    mask = jnp.tril(jnp.ones((C, C), dtype=bool))[None, :, :, None, None]

    def step(S, inp):
        qc, lfc, kc, vc = inp
        b = jnp.cumsum(lfc, axis=1)
        o_inter = jnp.einsum('bthk,bhkv->bthv', qc * jnp.exp(b), S)
        diff = b[:, :, None] - b[:, None, :]
        decay = jnp.where(mask, jnp.exp(jnp.where(mask, diff, 0.0)), 0.0)
        scores = jnp.einsum('bthk,btshk,bshk->bhts', qc, decay, kc)
        o_intra = jnp.einsum('bhts,bshv->bthv', scores, vc)
        b_last = b[:, -1]
        S_new = jnp.exp(b_last)[..., None] * S + jnp.einsum(
            'bshk,bshv->bhkv', kc * jnp.exp(b_last[:, None] - b), vc)
        return S_new, o_inter + o_intra

    s_final, o = lax.scan(step, s0, (to_chunks(q), to_chunks(logf), to_chunks(k), to_chunks(v)))
    o = o.transpose(1, 0, 2, 3, 4).reshape(B, n_chunks * C, H, v.shape[-1])[:, :L]
    return o, s_final


def _chunk_spatial_mix(v, w_s, b_s):
    B, L, H, E = v.shape
    n_chunks = -(-L // CHUNK_B)
    pad = n_chunks * CHUNK_B - L
    vc = jnp.pad(v, ((0, 0), (0, pad), (0, 0), (0, 0))).reshape(B, n_chunks, CHUNK_B, H, E)
    w_causal = jnp.where(jnp.tril(jnp.ones((CHUNK_B, CHUNK_B), dtype=bool))[None], w_s, 0.0)
    out = jnp.einsum('hts,bnshe->bnthe', w_causal, vc) + b_s.T[None, None, :, :, None]
    return out.reshape(B, n_chunks * CHUNK_B, H, E)[:, :L]


def _mixer_layer(x, s0, lb, norm_g, w_in, hgrn_norm_g, sgu_ln_g, sgu_ln_b, w_s, b_s, w_out):
    B, L, _ = x.shape
    h = _rms_norm(x, norm_g)
    proj = jnp.einsum('bld,de->ble', h, w_in)
    splits = [D_A, 2 * D_A, 3 * D_A, 4 * D_A, 4 * D_A + D_B, 4 * D_A + 2 * D_B]
    q, f, i, z_a, u, v, z_b = jnp.split(proj, splits, axis=-1)

    qf = jax.nn.silu(q.astype(jnp.float32)).reshape(B, L, H_A, DK)
    lbr = lb.reshape(H_A, DK)
    forget = lbr + (1.0 - lbr) * jax.nn.sigmoid(f.astype(jnp.float32)).reshape(B, L, H_A, DK)
    logf = jnp.log(forget)
    k = 1.0 - forget
    vi = i.astype(jnp.float32).reshape(B, L, H_A, DV)
    o_a, s_new = _hgrn2_chunked(qf, logf, k, vi, s0.astype(jnp.float32))
    o_a = _rms_norm(o_a, hgrn_norm_g.reshape(H_A, DV)).reshape(B, L, D_A)
    o_a = o_a * jax.nn.silu(z_a.astype(jnp.float32))

    u = jax.nn.gelu(u)
    v_n = _layer_norm(jax.nn.gelu(v), sgu_ln_g, sgu_ln_b).reshape(B, L, H_B, HEAD_B)
    sgu = u.reshape(B, L, H_B, HEAD_B) * _chunk_spatial_mix(v_n, w_s, b_s)
    o_b = sgu.reshape(B, L, D_B) * jax.nn.silu(z_b)

    mixed = jnp.concatenate([o_a.astype(x.dtype), o_b.astype(x.dtype)], axis=-1)
    out = x + jnp.einsum('ble,ed->bld', mixed, w_out)
    n_open = L - ((L - 1) // CHUNK_B) * CHUNK_B
    v_open = v_n[:, L - n_open:]
    return out, s_new.astype(s0.dtype), v_open


def setup_inputs(seed: int = 0) -> dict:
    key = jax.random.key(seed)
    ks = jax.random.split(key, 14)
    f32 = jnp.float32
    x_prompt = jax.random.normal(ks[0], (BATCH, SEQ, D_MODEL), f32)
    x_sample = jax.random.normal(ks[1], (DEC_BATCH, DEC_SEQ, D_MODEL), f32)
    state_hgrn = 0.3 * jax.random.normal(ks[2], (DEPTH, DEC_BATCH, H_A, DK, DV), f32)
    norm_g = 1.0 + 0.02 * jax.random.normal(ks[3], (DEPTH, D_MODEL), f32)
    w_in = jax.random.normal(ks[4], (DEPTH, D_MODEL, D_IN), f32) * D_MODEL ** -0.5
    lb_logits = 0.5 * jax.random.normal(ks[5], (DEPTH + 1, D_A), f32)
    hgrn_norm_g = 1.0 + 0.02 * jax.random.normal(ks[6], (DEPTH, D_A), f32)
    sgu_ln_g = 1.0 + 0.02 * jax.random.normal(ks[7], (DEPTH, D_B), f32)
    sgu_ln_b = 0.02 * jax.random.normal(ks[8], (DEPTH, D_B), f32)
    w_s = jax.random.normal(ks[9], (DEPTH, H_B, CHUNK_B, CHUNK_B), f32) * CHUNK_B ** -0.5
    b_s = 1.0 + 0.1 * jax.random.normal(ks[10], (DEPTH, H_B, CHUNK_B), f32)
    w_out = jax.random.normal(ks[11], (DEPTH, D_MIX, D_MODEL), f32) * D_MIX ** -0.5
    final_norm_g = 1.0 + 0.02 * jax.random.normal(ks[12], (D_MODEL,), f32)
    return {"x_prompt": x_prompt, "x_sample": x_sample, "state_hgrn": state_hgrn,
            "norm_g": norm_g, "w_in": w_in, "lb_logits": lb_logits,
            "hgrn_norm_g": hgrn_norm_g, "sgu_ln_g": sgu_ln_g, "sgu_ln_b": sgu_ln_b,
            "w_s": w_s, "b_s": b_s, "w_out": w_out, "final_norm_g": final_norm_g}


def reference(x_prompt, x_sample, state_hgrn, norm_g, w_in, lb_logits, hgrn_norm_g,
              sgu_ln_g, sgu_ln_b, w_s, b_s, w_out, final_norm_g):
    lower_bounds = jnp.cumsum(jax.nn.softmax(lb_logits.astype(jnp.float32), axis=0), axis=0)
    B = x_prompt.shape[0]
    xp, xs = x_prompt, x_sample
    sp_list, ss_list, vp_list, vs_list = [], [], [], []
    for l in range(DEPTH):
        lw = (lower_bounds[l], norm_g[l], w_in[l], hgrn_norm_g[l], sgu_ln_g[l], sgu_ln_b[l],
              w_s[l], b_s[l], w_out[l])
        s0_p = jnp.zeros((B, H_A, DK, DV), state_hgrn.dtype)
        xp, sp, vp = _mixer_layer(xp, s0_p, *lw)
        xs, ss, vs = _mixer_layer(xs, state_hgrn[l], *lw)
        sp_list.append(sp); ss_list.append(ss); vp_list.append(vp); vs_list.append(vs)
    y_prompt = _rms_norm(xp, final_norm_g)
    y_sample = _rms_norm(xs, final_norm_g)
    state_hgrn_prompt = jnp.stack(sp_list, axis=0)
    state_hgrn_sample = jnp.stack(ss_list, axis=0)
    v_chunk_prompt = jnp.stack(vp_list, axis=0)
    v_chunk_sample = jnp.stack(vs_list, axis=0)
    return (y_prompt, y_sample, state_hgrn_prompt, state_hgrn_sample, v_chunk_prompt, v_chunk_sample)
```

```cpp
#include <hip/hip_runtime.h>
#include <hip/hip_cooperative_groups.h>
#include <cstdio>
namespace cg = cooperative_groups;

#define LAS __attribute__((address_space(3)))
typedef unsigned short bf16_t;
typedef short bf16x8 __attribute__((ext_vector_type(8)));
typedef float f32x4 __attribute__((ext_vector_type(4)));
typedef float f32x2 __attribute__((ext_vector_type(2)));
typedef __bf16 bf16x2_t __attribute__((ext_vector_type(2)));
typedef unsigned u32x4 __attribute__((ext_vector_type(4)));
typedef unsigned u32x2 __attribute__((ext_vector_type(2)));
typedef _Float16 f16x2_t __attribute__((ext_vector_type(2)));

constexpr int T = 17408, TP = 16384, DM = 1024, DIN = 3584;
constexpr float EPS = 1e-6f;
constexpr int LDS_BYTES = 134144;
constexpr int R0 = 1, R2 = 1, R3 = 1, R4 = 1;
constexpr int NG2 = 16;
constexpr int XCD_BAR_WORDS_C = 3456;
constexpr int LDS_ST_OFF = 134128;

constexpr size_t WS_XB = 0;
constexpr size_t WS_RN = WS_XB + (size_t)T * DM * 2;
constexpr size_t WS_RSP = WS_RN + (size_t)T * 4;
constexpr size_t WS_WINT = WS_RSP + (size_t)16 * T * 4;
constexpr size_t WS_WOUTT = WS_WINT + (size_t)DIN * DM * 2;
constexpr size_t WS_Q = WS_WOUTT + (size_t)DM * DM * 2;
constexpr size_t WS_VI = WS_Q + (size_t)T * 512 * 2;
constexpr size_t WS_ZA = WS_VI + (size_t)T * 512 * 2;
constexpr size_t WS_U = WS_ZA + (size_t)T * 512 * 2;
constexpr size_t WS_VG = WS_U + (size_t)T * 512 * 2;
constexpr size_t WS_ZB = WS_VG + (size_t)T * 512 * 2;
constexpr size_t WS_LF = WS_ZB + (size_t)T * 512 * 2;
constexpr size_t WS_DEC = WS_LF + (size_t)T * 512 * 4;
constexpr size_t WS_SST = WS_DEC + (size_t)1024 * 128 * 4;
constexpr size_t WS_MIX = WS_SST + (size_t)1024 * 128 * 128 * 2;
constexpr size_t WS_VST = WS_MIX + (size_t)T * DM * 2;
constexpr size_t WS_BAR = WS_VST + (size_t)16 * T * 4;
constexpr int PC_STRIDE = 64;
constexpr int SCN_OFF = XCD_BAR_WORDS_C + 68 * PC_STRIDE, SCN_STRIDE = 16;
constexpr int RDY_OFF = XCD_BAR_WORDS_C + 68 * PC_STRIDE + 32 * 16, RDY_STRIDE = 16;
constexpr size_t BAR_BYTES = (size_t)(XCD_BAR_WORDS_C + 68 * PC_STRIDE + 32 * 16 + 64 * 16) * 4;
constexpr size_t WS_END = WS_BAR + BAR_BYTES;

constexpr size_t O_Y = 0;
constexpr size_t O_SP = (size_t)T * DM;
constexpr size_t O_SS = O_SP + 524288;
constexpr size_t O_VP = O_SS + 8388608;
constexpr size_t O_VS = O_VP + 524288;

struct Params {
  const float* xp; const float* xs; const float* st0; const float* norm_g; const float* w_in; const float* lbl;
  const float* hgn; const float* lng; const float* lnb; const float* w_s; const float* b_s; const float* w_out; const float* fng;
  float* out; unsigned char* ws; int use_cg; int pad;
};

__device__ __forceinline__ int opaque_tid() { int t = threadIdx.x; asm volatile("" : "+v"(t)); return t; }
__device__ __forceinline__ float bf_lo(unsigned u) { return __uint_as_float(u << 16); }
__device__ __forceinline__ float bf_hi(unsigned u) { return __uint_as_float(u & 0xffff0000u); }
__device__ __forceinline__ float bf2f(bf16_t b) { return __uint_as_float(((unsigned)b) << 16); }
__device__ __forceinline__ unsigned pack2(float lo, float hi) { f32x2 v = {lo, hi}; bf16x2_t b = __builtin_convertvector(v, bf16x2_t); return __builtin_bit_cast(unsigned, b); }
__device__ __forceinline__ bf16_t f2bf(float f) { return (bf16_t)(pack2(f, 0.f) & 0xffffu); }
__device__ __forceinline__ unsigned pack2h(float lo, float hi) { f32x2 v = {lo, hi}; f16x2_t b = __builtin_convertvector(v, f16x2_t); return __builtin_bit_cast(unsigned, b); }
typedef _Float16 f16x4_t __attribute__((ext_vector_type(4)));
__device__ __forceinline__ f32x4 unpack4h(u32x2 u) { const f16x4_t h = __builtin_bit_cast(f16x4_t, u); return __builtin_convertvector(h, f32x4); }
__device__ __forceinline__ float fsigmoid(float x) { return __builtin_amdgcn_rcpf(1.f + __expf(-x)); }
__device__ __forceinline__ bf16x8 pack8(const float (&a)[8]) {
  u32x4 u = {pack2(a[0], a[1]), pack2(a[2], a[3]), pack2(a[4], a[5]), pack2(a[6], a[7])};
  return __builtin_bit_cast(bf16x8, u);
}
__device__ __forceinline__ void unpack8(u32x4 u, float (&a)[8]) {
#pragma unroll
  for (int j = 0; j < 4; ++j) { a[2 * j] = bf_lo(u[j]); a[2 * j + 1] = bf_hi(u[j]); }
}


#define XB_TMO      128
#define XB_XCNT(j)  (256  + 64 * (j))
#define XB_XSUB(j)  (1280 + 64 * (j))
#define XB_XGEN(j)  (2304 + 64 * (j))
#define XB_TOP      3328
#define XB_TOPGEN   3392
#define XCD_BAR_WORDS 3456
#define XB_SPIN_CAP (1u << 18)
__device__ __forceinline__ unsigned xb_ld(unsigned* p)              { return __hip_atomic_load(p, __ATOMIC_RELAXED, __HIP_MEMORY_SCOPE_AGENT); }
__device__ __forceinline__ unsigned xb_add(unsigned* p, unsigned v) { return __hip_atomic_fetch_add(p, v, __ATOMIC_RELAXED, __HIP_MEMORY_SCOPE_AGENT); }
__device__ __forceinline__ unsigned xb_xcc_id() { return (unsigned)__builtin_amdgcn_s_getreg((3 << 11) | 20) & 0xFu; }
#define XB_SPIN(cond, bar) do { unsigned _sp = 0; while (cond) { __builtin_amdgcn_s_sleep(1); \
    if ((++_sp & 255u) == 0u) { if (xb_ld(&(bar)[XB_TMO])) break; if (_sp > XB_SPIN_CAP) { atomicAdd(&(bar)[XB_TMO], 1u); break; } } } } while (0)
struct XcdBarrier { unsigned* bar; unsigned x; volatile LAS unsigned* st; };
__device__ __forceinline__ XcdBarrier xcd_barrier_post(unsigned* bar, volatile LAS unsigned* st) {
  XcdBarrier b; b.bar = bar; b.x = xb_xcc_id(); b.st = st;
  if (threadIdx.x == 0) (void)xb_add(&bar[XB_XCNT(b.x)], 1u);
  return b;
}
__device__ __forceinline__ void xcd_barrier_complete(unsigned* bar, unsigned x, unsigned& nloc, unsigned& nx) {
  const unsigned G = gridDim.x * gridDim.y * gridDim.z;
  unsigned sum, cnt, mine, sp = 0u;
  for (;;) {
    sum = 0u; cnt = 0u; mine = 0u;
#pragma unroll
    for (unsigned j = 0; j < 16; ++j) { const unsigned c = xb_ld(&bar[XB_XCNT(j)]); sum += c; cnt += (c > 0u) ? 1u : 0u; mine = (j == x) ? c : mine; }
    if (sum == G) break;
    __builtin_amdgcn_s_sleep(1);
    if ((++sp & 255u) == 0u) { if (xb_ld(&bar[XB_TMO])) break; if (sp > XB_SPIN_CAP) { atomicAdd(&bar[XB_TMO], 1u); break; } }
  }
  nloc = mine > 0u ? mine : 1u; nx = cnt > 0u ? cnt : 1u;
}
__device__ __forceinline__ void xcd_barrier(const XcdBarrier& b) {
  asm volatile("s_waitcnt vmcnt(0)" ::: "memory");
  __syncthreads();
  if (threadIdx.x == 0) {
    unsigned* bar = b.bar;
    __builtin_amdgcn_s_waitcnt(0);
    unsigned nloc = b.st[0], nx = b.st[1];
    if (nloc == 0u) { xcd_barrier_complete(bar, b.x, nloc, nx); b.st[0] = nloc; b.st[1] = nx; }
    const unsigned old = xb_add(&bar[XB_XSUB(b.x)], 1u);
    const unsigned gen = old / nloc;
    if (old + 1u == (gen + 1u) * nloc) {
      __builtin_amdgcn_fence(__ATOMIC_RELEASE, "agent");
      asm volatile("s_waitcnt vmcnt(0)" ::: "memory");
      const unsigned og = xb_add(&bar[XB_TOP], 1u);
      const unsigned tg = og / nx;
      if (og + 1u == (tg + 1u) * nx) xb_add(&bar[XB_TOPGEN], 1u);
      else XB_SPIN(xb_ld(&bar[XB_TOPGEN]) == tg, bar);
      __builtin_amdgcn_fence(__ATOMIC_ACQUIRE, "agent");
      xb_add(&bar[XB_XGEN(b.x)], 1u);
      asm volatile("s_waitcnt vmcnt(0)" ::: "memory");
    } else {
      XB_SPIN(xb_ld(&bar[XB_XGEN(b.x)]) == gen, bar);
      __builtin_amdgcn_fence(__ATOMIC_ACQUIRE, "agent");
      asm volatile("s_waitcnt vmcnt(0)" ::: "memory");
    }
  }
  __syncthreads();
}

constexpr int BM = 256, BK = 64, HALF = 128, HTB = HALF * BK * 2, NXCD = 8, WGM = 8;
__device__ __forceinline__ int lds_byte(int r, int c) { const int st = (r >> 4) * 2 + (c >> 5), rr = r & 15, cc = c & 31, ob = rr * 64 + cc * 2; return st * 1024 + (ob ^ (((ob >> 9) & 1) << 5)); }
__device__ __forceinline__ void stage_rc(int b, int& R, int& C) { const int st = b / 1024, sb = b % 1024, swz = sb ^ (((sb >> 9) & 1) << 5); R = (st >> 1) * 16 + swz / 64; C = (st & 1) * 32 + (swz % 64) / 2; }
struct Unit { int pm, pn; };
struct Gemm { const bf16_t* A; const bf16_t* Bt; int M, N, K; };
struct StaticOrder {
  int nM, nN, nwg, G, c;
  __device__ void init(int M, int N, int G_, int c_) { nM = M / BM; nN = N / BM; nwg = nM * nN; G = G_; c = c_; }
  __device__ bool next(int i, Unit& u) const {
    const long L = (long)i * G + c; if (L >= nwg) return false;
    int wgid = (int)L; { const int q = nwg / NXCD, r = nwg % NXCD, xcd = wgid % NXCD, off = wgid / NXCD; wgid = (xcd < r ? xcd * (q + 1) : r * (q + 1) + (xcd - r) * q) + off; }
    const int nig = WGM * nN, gid = wgid / nig, fm = gid * WGM, gsz = (nM - fm) < WGM ? (nM - fm) : WGM;
    u.pm = fm + ((wgid % nig) % gsz); u.pn = (wgid % nig) / gsz; return true;
  }
};

template <class Epi>
__device__ __forceinline__ void gemm_phase(LAS unsigned char* lds, const Gemm g, const StaticOrder& S, const Epi& E, const unsigned* ready = nullptr, unsigned need = 0u) {
  int tid_ = threadIdx.x; asm volatile("" : "+v"(tid_));
  const int tid = tid_, wid = __builtin_amdgcn_readfirstlane(tid >> 6), lane = tid & 63, wr = wid >> 2, wc = wid & 3, fr = lane & 15, fq = lane >> 4;
  constexpr int K = DM, nt = K / BK;
  unsigned voffA[2], voffB[2];
#pragma unroll
  for (int i = 0; i < 2; ++i) { int R, C; stage_rc(tid * 16 + i * 8192, R, C); const int rho = R & 31, Rb = (R & ~31) + 8 * ((rho & 15) >> 2) + 4 * (rho >> 4) + (rho & 3);
    voffA[i] = (unsigned)(R * K + C) * 2u; voffB[i] = (unsigned)(Rb * K + C) * 2u; }
  const size_t kstep = (size_t)(BK * 2);
  const size_t hstep = (size_t)HALF * K * 2;
  const size_t tstep = 2 * hstep;
  const unsigned ldsw = (unsigned)wid * 1024u;
  const int aoff = lds_byte(wr * 64 + fr, fq * 8), boff = lds_byte(wc * 32 + fr, fq * 8);
#define PG8_SA(b, h) (((b) * 2 + (h)) * HTB)
#define PG8_SB(b, h) ((4 + (b) * 2 + (h)) * HTB)
#define PG8_STAGE(bufoff, gbase, voff) do { _Pragma("unroll") for (int _i = 0; _i < 2; ++_i) \
    __builtin_amdgcn_global_load_lds((const unsigned*)((const char*)(gbase) + (voff)[_i]), (LAS unsigned*)(lds + (bufoff) + ldsw + _i * 8192), 16, 0, 0); } while (0)
#define PG8_LDA(dst, b, h) do { _Pragma("unroll") for (int m = 0; m < 4; ++m) _Pragma("unroll") for (int k = 0; k < 2; ++k) dst[m][k] = *(const LAS bf16x8*)(lds + PG8_SA(b, h) + aoff + m * 2048 + k * 1024); } while (0)
#define PG8_LDB(dst, b, h) do { _Pragma("unroll") for (int n = 0; n < 2; ++n) _Pragma("unroll") for (int k = 0; k < 2; ++k) dst[n][k] = *(const LAS bf16x8*)(lds + PG8_SB(b, h) + boff + n * 2048 + k * 1024); } while (0)
#define PG8_MMA(ai, bj, At, Bt) do { __builtin_amdgcn_s_setprio(1); _Pragma("unroll") for (int m = 0; m < 4; ++m) _Pragma("unroll") for (int n = 0; n < 2; ++n) _Pragma("unroll") for (int k = 0; k < 2; ++k) \
    acc[ai][bj][m][n] = __builtin_amdgcn_mfma_f32_16x16x32_bf16(Bt[n][k], At[m][k], acc[ai][bj][m][n], 0, 0, 0); __builtin_amdgcn_s_setprio(0); } while (0)
#define PG8_WAIT_V(n) asm volatile("s_waitcnt vmcnt(" #n ")" ::: "memory")
#define PG8_WAIT_L(n) asm volatile("s_waitcnt lgkmcnt(" #n ")" ::: "memory")
#define PG8_BAR __builtin_amdgcn_s_barrier()
#define PG8_SCHED __builtin_amdgcn_sched_barrier(0)
  Unit cur, nxt; int ui = 0;
  if (!S.next(0, cur)) return;
  f32x4 acc[2][2][4][2];
#pragma unroll
  for (int a = 0; a < 2; ++a)
#pragma unroll
    for (int b = 0; b < 2; ++b)
#pragma unroll
      for (int m = 0; m < 4; ++m)
#pragma unroll
        for (int n = 0; n < 2; ++n) acc[a][b][m][n] = (f32x4){0.f, 0.f, 0.f, 0.f};
  bf16x8 At[4][2], B0[2][2], B1[2][2];
  const char* cA = (const char*)g.A + (size_t)cur.pm * tstep; const char* cB = (const char*)g.Bt + (size_t)cur.pn * tstep;
  if (ready) {
    if (tid < 64) { unsigned sp = 0u;
      while ((unsigned)__builtin_amdgcn_readfirstlane(__hip_atomic_load(ready + (size_t)cur.pm * RDY_STRIDE, __ATOMIC_RELAXED, __HIP_MEMORY_SCOPE_AGENT)) < need) { __builtin_amdgcn_s_sleep(2); if (++sp > (1u << 21)) break; }
      __builtin_amdgcn_fence(__ATOMIC_ACQUIRE, "agent");
      asm volatile("s_waitcnt vmcnt(0)" ::: "memory"); }
    asm volatile("" ::: "memory"); __builtin_amdgcn_s_barrier(); asm volatile("" ::: "memory"); }
  PG8_STAGE(PG8_SB(0, 0), cB, voffB); PG8_STAGE(PG8_SB(0, 1), cB + hstep, voffB); PG8_STAGE(PG8_SA(0, 0), cA, voffA); PG8_STAGE(PG8_SA(0, 1), cA + hstep, voffA);
  if (wr == 1) PG8_BAR;
  PG8_WAIT_V(2); PG8_BAR;
  PG8_STAGE(PG8_SB(1, 0), cB + kstep, voffB); PG8_STAGE(PG8_SA(1, 0), cA + kstep, voffA); PG8_STAGE(PG8_SB(1, 1), cB + hstep + kstep, voffB);
  PG8_WAIT_V(6); PG8_BAR;
  for (;;) {
    const bool has_next = S.next(ui + 1, nxt);
    const char* nA = has_next ? (const char*)g.A + (size_t)nxt.pm * tstep : cA; const char* nB = has_next ? (const char*)g.Bt + (size_t)nxt.pn * tstep : cB;
    for (int t = 0; t < nt; t += 2) {
      const bool last = (t == nt - 2);
      const char* a1 = cA + (size_t)(t + 1) * kstep;
      const char* a2 = last ? nA : cA + (size_t)(t + 2) * kstep; const char* b2 = last ? nB : cB + (size_t)(t + 2) * kstep;
      const char* a3 = a2 + kstep; const char* b3 = b2 + kstep;
      PG8_LDB(B0, 0, 0); PG8_LDB(B1, 0, 1); PG8_SCHED; PG8_LDA(At, 0, 0); PG8_STAGE(PG8_SA(1, 1), a1 + hstep, voffA);
      PG8_WAIT_V(8); PG8_WAIT_L(0); PG8_BAR; PG8_MMA(0, 0, At, B0); PG8_MMA(0, 1, At, B1); PG8_BAR; PG8_SCHED;
      PG8_LDA(At, 0, 1); PG8_STAGE(PG8_SB(0, 0), b2, voffB); PG8_STAGE(PG8_SB(0, 1), b2 + hstep, voffB); PG8_STAGE(PG8_SA(0, 0), a2, voffA);
      PG8_WAIT_V(8); PG8_WAIT_L(0); PG8_BAR; PG8_MMA(1, 0, At, B0); PG8_MMA(1, 1, At, B1); PG8_BAR; PG8_SCHED;
      PG8_LDB(B0, 1, 0); PG8_LDB(B1, 1, 1); PG8_SCHED; PG8_LDA(At, 1, 0); PG8_STAGE(PG8_SA(0, 1), a2 + hstep, voffA);
      PG8_WAIT_V(8); PG8_WAIT_L(0); PG8_BAR; PG8_MMA(0, 0, At, B0); PG8_MMA(0, 1, At, B1); PG8_BAR; PG8_SCHED;
      PG8_LDA(At, 1, 1); PG8_STAGE(PG8_SB(1, 0), b3, voffB); PG8_STAGE(PG8_SB(1, 1), b3 + hstep, voffB); PG8_STAGE(PG8_SA(1, 0), a3, voffA);
      PG8_WAIT_V(8); PG8_WAIT_L(0); PG8_BAR; PG8_MMA(1, 0, At, B0); PG8_MMA(1, 1, At, B1); PG8_BAR; PG8_SCHED;
    }
    if constexpr (!Epi::AFTER_DRAIN) { if (wr == 0) PG8_BAR;
      E(acc, cur, wr, wc, fr, fq); }
    if (!has_next) break;
#pragma unroll
    for (int a = 0; a < 2; ++a)
#pragma unroll
      for (int b = 0; b < 2; ++b)
#pragma unroll
        for (int m = 0; m < 4; ++m)
#pragma unroll
          for (int n = 0; n < 2; ++n) acc[a][b][m][n] = (f32x4){0.f, 0.f, 0.f, 0.f};
    cur = nxt; cA = nA; cB = nB; ++ui;
    if constexpr (!Epi::AFTER_DRAIN) { if (wr == 1) PG8_BAR; }
  }
  PG8_WAIT_V(0);
  if constexpr (Epi::AFTER_DRAIN) { if (wr == 0) PG8_BAR; }
  PG8_BAR;
  if constexpr (Epi::AFTER_DRAIN) E.fused(acc, cur, wr, wc, fr, fq);
#undef PG8_SA
#undef PG8_SB
#undef PG8_STAGE
#undef PG8_LDA
#undef PG8_LDB
#undef PG8_MMA
#undef PG8_WAIT_V
#undef PG8_WAIT_L
#undef PG8_BAR
#undef PG8_SCHED
}

struct Epi1 {
  static constexpr bool AFTER_DRAIN = false;
  const float* rn; const float* lbl; bf16_t* Q; bf16_t* VI; bf16_t* ZA; bf16_t* U; bf16_t* VG; bf16_t* ZB; float* LF; float* VST;
  __device__ __forceinline__ void operator()(const f32x4 (&acc)[2][2][4][2], const Unit& u, int wr, int wc, int fr, int fq) const {
    const int row0 = u.pm * BM + wr * 64 + fr; const int type = u.pn < 8 ? (u.pn >> 1) : (u.pn < 12 ? 7 : 5);
    const int col0 = (u.pn & 1) * 256 + wc * 32 + 8 * fq;
    float sc[2][4];
#pragma unroll
    for (int ai = 0; ai < 2; ++ai)
#pragma unroll
      for (int m = 0; m < 4; ++m) sc[ai][m] = 1.f;
    if (type == 1) {
      f32x4 lb[2][2];
#pragma unroll
      for (int bj = 0; bj < 2; ++bj)
#pragma unroll
        for (int n = 0; n < 2; ++n) { const int c = col0 + bj * HALF + n * 4; const f32x4 l0 = *(const f32x4*)(lbl + c), l1 = *(const f32x4*)(lbl + 512 + c);
#pragma unroll
          for (int j = 0; j < 4; ++j) lb[bj][n][j] = __builtin_amdgcn_rcpf(1.f + __expf(l1[j] - l0[j])); }
#pragma unroll
      for (int ai = 0; ai < 2; ++ai)
#pragma unroll
        for (int m = 0; m < 4; ++m) { const int r = row0 + ai * HALF + m * 16; const float s = sc[ai][m]; _Float16* rowp = (_Float16*)LF + (size_t)r * 512 + col0;
#pragma unroll
          for (int bj = 0; bj < 2; ++bj) { float o[8];
#pragma unroll
            for (int n = 0; n < 2; ++n)
#pragma unroll
              for (int j = 0; j < 4; ++j) { const float v = acc[ai][bj][m][n][j] * s; const float l = lb[bj][n][j]; o[4 * n + j] = __builtin_amdgcn_logf(l + (1.f - l) * fsigmoid(v)); }
            const u32x4 pk = {pack2h(o[0], o[1]), pack2h(o[2], o[3]), pack2h(o[4], o[5]), pack2h(o[6], o[7])};
            *(u32x4*)(rowp + bj * HALF) = pk; } }
    } else if (type == 7) {
      bf16_t* base = U + (size_t)(u.pn - 8) * 128 + wc * 32 + 8 * fq;
#pragma unroll
      for (int ai = 0; ai < 2; ++ai)
#pragma unroll
        for (int m = 0; m < 4; ++m) { const int r = row0 + ai * HALF + m * 16; const float s = sc[ai][m]; float o[8];
#pragma unroll
          for (int n = 0; n < 2; ++n)
#pragma unroll
            for (int j = 0; j < 4; ++j) { const float uu = acc[ai][0][m][n][j] * s, zz = acc[ai][1][m][n][j] * s;
              const float ea = __expf(-1.5957691216f * (uu + 0.044715f * uu * uu * uu)), eb = __expf(-zz);
              o[4 * n + j] = uu * zz * __builtin_amdgcn_rcpf((1.f + ea) * (1.f + eb)); }
          const u32x4 pk = {pack2(o[0], o[1]), pack2(o[2], o[3]), pack2(o[4], o[5]), pack2(o[6], o[7])};
          *(u32x4*)(base + (size_t)r * 512) = pk; }
    } else {
      bf16_t* base = type == 0 ? Q : type == 2 ? VI : type == 3 ? ZA : VG;
      const int act = (type == 2) ? 0 : (type == 5) ? 2 : 1;
#pragma unroll
      for (int ai = 0; ai < 2; ++ai)
#pragma unroll
        for (int m = 0; m < 4; ++m) { const int r = row0 + ai * HALF + m * 16; const float s = sc[ai][m]; bf16_t* rowp = base + (size_t)r * 512 + col0; float s1 = 0.f, s2 = 0.f;
#pragma unroll
          for (int bj = 0; bj < 2; ++bj) { float o[8];
#pragma unroll
            for (int n = 0; n < 2; ++n)
#pragma unroll
              for (int j = 0; j < 4; ++j) { const float v = acc[ai][bj][m][n][j] * s; const float tt = (act == 2) ? 1.5957691216f * (v + 0.044715f * v * v * v) : v;
                const float sg = fsigmoid(tt); const float ov = (act == 0) ? v : v * sg; o[4 * n + j] = ov; if (type == 5) { s1 += ov; s2 += ov * ov; } }
            const u32x4 pk = {pack2(o[0], o[1]), pack2(o[2], o[3]), pack2(o[4], o[5]), pack2(o[6], o[7])};
            *(u32x4*)(rowp + bj * HALF) = pk; }
          if (type == 5) {
            s1 += __shfl_xor(s1, 16); s1 += __shfl_xor(s1, 32); s2 += __shfl_xor(s2, 16); s2 += __shfl_xor(s2, 32);
            if (fq == 0) { float* vp = VST + (size_t)(((u.pn & 1) * 4 + wc) * 2) * T + r; vp[0] = s1; vp[T] = s2; } } }
    }
  }
};

struct Epi2 {
  static constexpr bool AFTER_DRAIN = true;
  const bf16_t* xb; const float* fng; float* y; float* rsp; unsigned* pc; int rowoff; const float* rinv;
  __device__ __forceinline__ void fused(f32x4 (&acc)[2][2][4][2], const Unit& u, int wr, int wc, int fr, int fq) const {
    const int row0 = rowoff + u.pm * BM + wr * 64 + fr; const int col0 = u.pn * BM + wc * 32 + 8 * fq;
    float rv[8];
#pragma unroll
    for (int it = 0; it < 8; ++it) rv[it] = rinv[row0 + (it >> 2) * HALF + (it & 3) * 16];
    u32x2 xv[2][4];
    { const bf16_t* xr = xb + (size_t)row0 * DM + col0;
#pragma unroll
      for (int q = 0; q < 4; ++q) xv[0][q] = __builtin_nontemporal_load((const u32x2*)(xr + (q >> 1) * HALF + (q & 1) * 4)); }
#pragma unroll
    for (int it = 0; it < 8; ++it) { const int ai = it >> 2, m = it & 3; const int r = row0 + ai * HALF + m * 16;
      if (it < 7) { const int r2 = row0 + ((it + 1) >> 2) * HALF + ((it + 1) & 3) * 16; const bf16_t* xr = xb + (size_t)r2 * DM + col0;
#pragma unroll
        for (int q = 0; q < 4; ++q) xv[(it + 1) & 1][q] = __builtin_nontemporal_load((const u32x2*)(xr + (q >> 1) * HALF + (q & 1) * 4)); }
      float ss = 0.f;
#pragma unroll
      for (int bj = 0; bj < 2; ++bj)
#pragma unroll
        for (int n = 0; n < 2; ++n) { const u32x2 xq = xv[it & 1][bj * 2 + n]; const f32x4 o = acc[ai][bj][m][n] + (f32x4){bf_lo(xq[0]), bf_hi(xq[0]), bf_lo(xq[1]), bf_hi(xq[1])} * rv[it]; acc[ai][bj][m][n] = o;
          ss += o[0] * o[0] + o[1] * o[1] + o[2] * o[2] + o[3] * o[3]; }
      ss += __shfl_xor(ss, 16); ss += __shfl_xor(ss, 32);
      if (fq == 0) __hip_atomic_store(rsp + (size_t)(u.pn * 4 + wc) * T + r, ss, __ATOMIC_RELAXED, __HIP_MEMORY_SCOPE_AGENT); }
    asm volatile("s_waitcnt vmcnt(0)" ::: "memory");
    __syncthreads();
    if (threadIdx.x == 0) {
      unsigned* c = pc + (size_t)(rowoff / BM + u.pm) * PC_STRIDE;
      (void)__hip_atomic_fetch_add(c, 1u, __ATOMIC_RELAXED, __HIP_MEMORY_SCOPE_AGENT);
      unsigned sp = 0u;
      while (__hip_atomic_load(c, __ATOMIC_RELAXED, __HIP_MEMORY_SCOPE_AGENT) < 4u) { __builtin_amdgcn_s_sleep(1); if (++sp > (1u << 22)) break; }
    }
    __syncthreads();
    float rs[2][4];
#pragma unroll
    for (int ai = 0; ai < 2; ++ai)
#pragma unroll
      for (int m = 0; m < 4; ++m) { const int r = row0 + ai * HALF + m * 16; float t = 0.f;
#pragma unroll
        for (int j = 0; j < 4; ++j) t += __hip_atomic_load(rsp + (size_t)(4 * fq + j) * T + r, __ATOMIC_RELAXED, __HIP_MEMORY_SCOPE_AGENT);
        t += __shfl_xor(t, 16); t += __shfl_xor(t, 32); rs[ai][m] = rsqrtf(t * (1.f / DM) + EPS); }
    f32x4 fg[2][2];
#pragma unroll
    for (int bj = 0; bj < 2; ++bj)
#pragma unroll
      for (int n = 0; n < 2; ++n) fg[bj][n] = *(const f32x4*)(fng + col0 + bj * HALF + n * 4);
#pragma unroll
    for (int ai = 0; ai < 2; ++ai)
#pragma unroll
      for (int m = 0; m < 4; ++m) { float* yr = y + (size_t)(row0 + ai * HALF + m * 16) * DM + col0;
#pragma unroll
        for (int bj = 0; bj < 2; ++bj)
#pragma unroll
          for (int n = 0; n < 2; ++n) *(f32x4*)(yr + bj * HALF + n * 4) = acc[ai][bj][m][n] * fg[bj][n] * rs[ai][m]; }
  }
};

__device__ __forceinline__ void wtiles(LAS unsigned char* lds, const Params& p, int first, int last, int start, int stride);
__device__ __forceinline__ void phase0(LAS unsigned char* lds, const Params& p) {
  const int tid = opaque_tid(), wid = tid >> 6, lane = tid & 63;
  bf16_t* XB = (bf16_t*)(p.ws + WS_XB); float* RN = (float*)(p.ws + WS_RN);
  for (int r0 = (blockIdx.x * 8 + wid) * 2; r0 < T; r0 += gridDim.x * 16) {
    f32x4 v[2][4]; float ss[2] = {0.f, 0.f};
#pragma unroll
    for (int q = 0; q < 2; ++q) { const int r = r0 + q; const float* xr = r < TP ? p.xp + (size_t)r * DM : p.xs + (size_t)(r - TP) * DM;
#pragma unroll
      for (int j = 0; j < 4; ++j) v[q][j] = __builtin_nontemporal_load((const f32x4*)(xr + j * 256 + lane * 4)); }
#pragma unroll
    for (int q = 0; q < 2; ++q) {
#pragma unroll
      for (int j = 0; j < 4; ++j) ss[q] += v[q][j][0] * v[q][j][0] + v[q][j][1] * v[q][j][1] + v[q][j][2] * v[q][j][2] + v[q][j][3] * v[q][j][3]; }
#pragma unroll
    for (int o = 32; o >= 1; o >>= 1) { ss[0] += __shfl_xor(ss[0], o); ss[1] += __shfl_xor(ss[1], o); }
    const float rq[2] = {rsqrtf(ss[0] * (1.f / DM) + EPS), rsqrtf(ss[1] * (1.f / DM) + EPS)};
    if (lane == 0) { RN[r0] = sqrtf(ss[0] * (1.f / DM) + EPS); RN[r0 + 1] = sqrtf(ss[1] * (1.f / DM) + EPS); }
#pragma unroll
    for (int q = 0; q < 2; ++q)
#pragma unroll
      for (int j = 0; j < 4; ++j) { const f32x4 w = v[q][j] * rq[q]; u32x2 pk = {pack2(w[0], w[1]), pack2(w[2], w[3])}; *(u32x2*)(XB + (size_t)(r0 + q) * DM + j * 256 + lane * 4) = pk; }
  }
  wtiles(lds, p, 0, 896, blockIdx.x, gridDim.x);
}

struct WTile { const float* src; bf16_t* dst; int ldn, kt, ntl, scol; bool fold; };
__device__ __forceinline__ WTile wtile_decode(const Params& p, int it) {
  WTile w; bf16_t* WINT = (bf16_t*)(p.ws + WS_WINT); bf16_t* WOUTT = (bf16_t*)(p.ws + WS_WOUTT);
  if (it < 896) { w.kt = it / 56; w.ntl = it % 56; w.src = p.w_in; w.ldn = DIN; w.dst = WINT; w.fold = true;
    const int n0 = w.ntl * 64;
    if (n0 < 2048) w.scol = n0;
    else if (n0 < 3072) { const int hh = (n0 - 2048) >> 8, c = (n0 - 2048) & 255; w.scol = c < 128 ? 2048 + hh * 128 + c : 3072 + hh * 128 + (c - 128); }
    else w.scol = 2560 + (n0 - 3072); }
  else { const int j = it - 896; w.kt = j / 16; w.ntl = j % 16; w.src = p.w_out; w.ldn = DM; w.dst = WOUTT; w.fold = false; w.scol = w.ntl * 64; }
  return w;
}
__device__ __forceinline__ void wtile_load(const Params& p, const WTile& w, int tid, f32x4 (&v)[2]) {
#pragma unroll
  for (int i = 0; i < 2; ++i) { const int r = (tid >> 4) + 32 * i, c4 = tid & 15;
    v[i] = __builtin_nontemporal_load((const f32x4*)(w.src + (size_t)(w.kt * 64 + r) * w.ldn + w.scol + c4 * 4)); const float g = w.fold ? p.norm_g[w.kt * 64 + r] : 1.f; v[i] = v[i] * g; }
}
__device__ __forceinline__ void wtiles(LAS unsigned char* lds, const Params& p, int first, int last, int start, int stride) {
  const int tid = opaque_tid(), wid = __builtin_amdgcn_readfirstlane(tid >> 6), lane = tid & 63;
  LAS float* tl = (LAS float*)(lds + wid * 16640);
  for (int it = first + wid * stride + start; it < last; it += stride * 8) {
    const WTile w = wtile_decode(p, it);
    f32x4 v[16];
#pragma unroll
    for (int i = 0; i < 16; ++i) { const int r = (lane >> 4) + 4 * i, c4 = lane & 15;
      v[i] = __builtin_nontemporal_load((const f32x4*)(w.src + (size_t)(w.kt * 64 + r) * w.ldn + w.scol + c4 * 4)); const float g = w.fold ? p.norm_g[w.kt * 64 + r] : 1.f; v[i] = v[i] * g; }
#pragma unroll
    for (int i = 0; i < 16; ++i) { const int r = (lane >> 4) + 4 * i, c4 = lane & 15;
#pragma unroll
      for (int j = 0; j < 4; ++j) tl[r * 65 + c4 * 4 + j] = v[i][j]; }
    asm volatile("s_waitcnt lgkmcnt(0)" ::: "memory");
#pragma unroll
    for (int i = 0; i < 8; ++i) { const int n = (lane >> 3) + 8 * i, k8 = lane & 7; float a[8];
#pragma unroll
      for (int j = 0; j < 8; ++j) a[j] = tl[(k8 * 8 + j) * 65 + n];
      const u32x4 pk = {pack2(a[0], a[1]), pack2(a[2], a[3]), pack2(a[4], a[5]), pack2(a[6], a[7])};
      *(u32x4*)(w.dst + (size_t)(w.ntl * 64 + n) * DM + w.kt * 64 + k8 * 8) = pk; }
    asm volatile("s_waitcnt lgkmcnt(0)" ::: "memory");
  }
}


__device__ __forceinline__ void tr_piece(int chunk, int lane, int& s, int& e8) { s = (chunk >> 1) * 8 + (lane >> 3); e8 = ((chunk & 1) * 8 + (lane & 7)) * 8; }
__device__ __forceinline__ void tr_write8(LAS bf16_t* Tm, int stride, int e8, int s, u32x4 v) {
  const int sp = s ^ (((e8 >> 3) & 7) << 3);
#pragma unroll
  for (int j = 0; j < 4; ++j) { Tm[(e8 + 2 * j) * stride + sp] = (bf16_t)(v[j] & 0xffffu); Tm[(e8 + 2 * j + 1) * stride + sp] = (bf16_t)(v[j] >> 16); }
}
__device__ __forceinline__ bf16x8 tr_read8(const LAS bf16_t* Tm, int stride, int e, int g0) { return *(const LAS bf16x8*)(Tm + e * stride + (g0 ^ (((e >> 3) & 7) << 3))); }

struct P2aPref { u32x2 lv[4]; u32x4 vv[2]; };
__device__ __forceinline__ void p2a_load(P2aPref& r, const Params& p, int it) {
  const int tid = opaque_tid(), wid = __builtin_amdgcn_readfirstlane(tid >> 6), lane = tid & 63;
  const int b = it >> 7, c = (it >> 2) & 31, h = it & 3, t0 = b * 2048 + c * 64;
  const float* LF = (const float*)(p.ws + WS_LF); const bf16_t* VI = (const bf16_t*)(p.ws + WS_VI);
#pragma unroll
  for (int i = 0; i < 4; ++i) { const int idx = tid + 512 * i, s = idx >> 5, c4 = idx & 31; r.lv[i] = *(const u32x2*)((const _Float16*)LF + (size_t)(t0 + s) * 512 + h * 128 + c4 * 4); }
#pragma unroll
  for (int i = 0; i < 2; ++i) { int vs, ve; tr_piece(wid + 8 * i, lane, vs, ve); r.vv[i] = *(const u32x4*)(VI + (size_t)(t0 + vs) * 512 + h * 128 + ve); }
}
__device__ __forceinline__ void p2a_item(LAS unsigned char* lds, const Params& p, int b, int c, int h, P2aPref& r, int nxt) {
  const int tid = opaque_tid(), wid = __builtin_amdgcn_readfirstlane(tid >> 6), lane = tid & 63, fr = lane & 15, fq = lane >> 4;
  LAS float* bL = (LAS float*)lds; LAS bf16_t* Vt = (LAS bf16_t*)(lds + 32768); LAS bf16_t* Kt = (LAS bf16_t*)(lds + 51200); LAS float* tot = (LAS float*)(lds + 69632);
  const float* LF = (const float*)(p.ws + WS_LF); const bf16_t* VI = (const bf16_t*)(p.ws + WS_VI); float* DEC = (float*)(p.ws + WS_DEC); bf16_t* SL = (bf16_t*)p.out;
  const int t0 = b * 2048 + c * 64, slot = (b * 4 + h) * 32 + c;
  {
#pragma unroll
    for (int i = 0; i < 4; ++i) { const int idx = tid + 512 * i, s = idx >> 5, c4 = idx & 31; *(LAS f32x4*)(bL + s * 128 + c4 * 4) = unpack4h(r.lv[i]); }
#pragma unroll
    for (int i = 0; i < 2; ++i) { int vs, ve; tr_piece(wid + 8 * i, lane, vs, ve); tr_write8(Vt, 72, ve, vs, r.vv[i]); } }
  __syncthreads();
  if (nxt < 1024) p2a_load(r, p, nxt);
  const int kk = tid & 127, jq = tid >> 7;
  float kreg[16]; float run = 0.f;
#pragma unroll
  for (int i = 0; i < 16; ++i) { const int s = 16 * jq + i; const float lf = bL[s * 128 + kk]; kreg[i] = 1.f - __builtin_amdgcn_exp2f(lf); run += lf; bL[s * 128 + kk] = run; }
  tot[jq * 128 + kk] = run;
  __syncthreads();
  float ref = 0.f, blast = 0.f;
#pragma unroll
  for (int j2 = 0; j2 < 4; ++j2) { const float tv = tot[j2 * 128 + kk]; if (j2 < jq) ref += tv; blast += tv; }
  { float kh[16];
#pragma unroll
    for (int i = 0; i < 16; ++i) { const int s = 16 * jq + i; const float bb = ref + bL[s * 128 + kk]; kh[i] = kreg[i] * __builtin_amdgcn_exp2f(blast - bb); }
    u32x4 w0 = {pack2(kh[0], kh[1]), pack2(kh[2], kh[3]), pack2(kh[4], kh[5]), pack2(kh[6], kh[7])}, w1 = {pack2(kh[8], kh[9]), pack2(kh[10], kh[11]), pack2(kh[12], kh[13]), pack2(kh[14], kh[15])};
    *(LAS u32x4*)(Kt + kk * 72 + 16 * jq) = w0; *(LAS u32x4*)(Kt + kk * 72 + 16 * jq + 8) = w1; }
  if (jq == 0) DEC[slot * 128 + kk] = __builtin_amdgcn_exp2f(blast);
  __syncthreads();
  bf16x8 A[2];
#pragma unroll
  for (int ks = 0; ks < 2; ++ks) A[ks] = *(const LAS bf16x8*)(Kt + (16 * wid + fr) * 72 + 32 * ks + 8 * fq);
#pragma unroll
  for (int nb = 0; nb < 8; ++nb) { f32x4 acc = {0.f, 0.f, 0.f, 0.f};
#pragma unroll
    for (int ks = 0; ks < 2; ++ks) { const bf16x8 B = tr_read8(Vt, 72, 16 * nb + fr, 32 * ks + 8 * fq); acc = __builtin_amdgcn_mfma_f32_16x16x32_bf16(B, A[ks], acc, 0, 0, 0); }
    u32x2 pk = {pack2(acc[0], acc[1]), pack2(acc[2], acc[3])};
    *(u32x2*)(SL + ((size_t)slot * 128 + 16 * wid + fr) * 128 + 16 * nb + 4 * fq) = pk; }
  __syncthreads();
}

__device__ __forceinline__ void p2b_item(LAS unsigned char* lds, const Params& p, int ti, int h) {
  const int tid = opaque_tid(), wid = __builtin_amdgcn_readfirstlane(tid >> 6), lane = tid & 63, fr = lane & 15, fq = lane >> 4;
  LAS bf16_t* vnt = (LAS bf16_t*)lds; LAS float* st = (LAS float*)(lds + 34816);
  const bf16_t* VG = (const bf16_t*)(p.ws + WS_VG); const bf16_t* U = (const bf16_t*)(p.ws + WS_U); const bf16_t* ZB = (const bf16_t*)(p.ws + WS_ZB); bf16_t* MIX = (bf16_t*)(p.ws + WS_MIX);
  const float* VST = (const float*)(p.ws + WS_VST);
  const int t0 = ti * 128; const bool sample = ti >= 128; const bool open = sample || ((ti & 15) == 15);
  u32x4 vg[4]; int ps[4], pe[4];
#pragma unroll
  for (int i = 0; i < 4; ++i) { tr_piece(wid + 8 * i, lane, ps[i], pe[i]); vg[i] = __builtin_nontemporal_load((const u32x4*)(VG + (size_t)(t0 + ps[i]) * 512 + h * 128 + pe[i])); }
  if (tid < 128) { float s1 = 0.f, s2 = 0.f;
#pragma unroll
    for (int j = 0; j < 8; ++j) { s1 += VST[(size_t)(2 * j) * T + t0 + tid]; s2 += VST[(size_t)(2 * j + 1) * T + t0 + tid]; }
    const float mu = s1 * (1.f / 512.f); const float var = fmaxf(s2 * (1.f / 512.f) - mu * mu, 0.f); st[2 * tid] = mu; st[2 * tid + 1] = rsqrtf(var + EPS); }
  const int t = 16 * wid + fr;
  f32x4 wv[4][2];
#pragma unroll
  for (int ks = 0; ks < 4; ++ks) { wv[ks][0] = (f32x4){0.f, 0.f, 0.f, 0.f}; wv[ks][1] = wv[ks][0];
    if (32 * ks <= 16 * wid + 15) { const int s0 = 32 * ks + 8 * fq;
      const float* wp = sample ? p.w_s + (size_t)(h * 128 + (t & 7)) * 128 : p.w_s + (size_t)(h * 128 + t) * 128 + s0;
      wv[ks][0] = *(const f32x4*)wp; wv[ks][1] = *(const f32x4*)(wp + 4); } }
  u32x2 uu[8];
#pragma unroll
  for (int nb = 0; nb < 8; ++nb) { const size_t g = (size_t)(t0 + t) * 512 + h * 128 + 16 * nb + 4 * fq; uu[nb] = __builtin_nontemporal_load((const u32x2*)(U + g)); }
  const float bias = p.b_s[h * 128 + (sample ? (t & 7) : t)];
  __syncthreads();
  float* vout = p.out + (sample ? O_VS + (size_t)(t0 - TP) * 512 : O_VP + (size_t)(ti >> 4) * 128 * 512);
#pragma unroll
  for (int i = 0; i < 4; ++i) { const int s = ps[i], e8 = pe[i]; float a[8]; unpack8(vg[i], a);
    const float mu = st[2 * s], rs = st[2 * s + 1]; const f32x4 g0 = *(const f32x4*)(p.lng + h * 128 + e8), g1 = *(const f32x4*)(p.lng + h * 128 + e8 + 4), b0 = *(const f32x4*)(p.lnb + h * 128 + e8), b1 = *(const f32x4*)(p.lnb + h * 128 + e8 + 4);
    float vn[8];
#pragma unroll
    for (int j = 0; j < 4; ++j) { vn[j] = (a[j] - mu) * rs * g0[j] + b0[j]; vn[4 + j] = (a[4 + j] - mu) * rs * g1[j] + b1[j]; }
    const u32x4 pk = {pack2(vn[0], vn[1]), pack2(vn[2], vn[3]), pack2(vn[4], vn[5]), pack2(vn[6], vn[7])};
    tr_write8(vnt, 136, e8, s, pk);
    if (open) { float* o = vout + (size_t)s * 512 + h * 128 + e8; *(f32x4*)o = (f32x4){vn[0], vn[1], vn[2], vn[3]}; *(f32x4*)(o + 4) = (f32x4){vn[4], vn[5], vn[6], vn[7]}; } }
  __syncthreads();
  bf16x8 A[4];
#pragma unroll
  for (int ks = 0; ks < 4; ++ks) { const int s0 = 32 * ks + 8 * fq; float a[8];
#pragma unroll
    for (int j = 0; j < 4; ++j) { a[j] = wv[ks][0][j]; a[4 + j] = wv[ks][1][j]; }
    if (sample) { const bool vb = (s0 >> 3) == (t >> 3);
#pragma unroll
      for (int j = 0; j < 8; ++j) a[j] = (vb && j <= (t & 7)) ? a[j] : 0.f; }
    else {
#pragma unroll
      for (int j = 0; j < 8; ++j) a[j] = (s0 + j <= t) ? a[j] : 0.f; }
    A[ks] = pack8(a); }
#pragma unroll
  for (int nb = 0; nb < 8; ++nb) { f32x4 acc = {0.f, 0.f, 0.f, 0.f};
#pragma unroll
    for (int ks = 0; ks < 4; ++ks) if (32 * ks <= 16 * wid + 15) { const bf16x8 B = tr_read8(vnt, 136, 16 * nb + fr, 32 * ks + 8 * fq); acc = __builtin_amdgcn_mfma_f32_16x16x32_bf16(B, A[ks], acc, 0, 0, 0); }
    const int e = 16 * nb + 4 * fq;
    const float o0 = (acc[0] + bias) * bf_lo(uu[nb][0]), o1 = (acc[1] + bias) * bf_hi(uu[nb][0]);
    const float o2 = (acc[2] + bias) * bf_lo(uu[nb][1]), o3 = (acc[3] + bias) * bf_hi(uu[nb][1]);
    u32x2 pk = {pack2(o0, o1), pack2(o2, o3)};
    *(u32x2*)(MIX + (size_t)(t0 + t) * DM + 512 + h * 128 + e) = pk; }
  __syncthreads();
}

struct P2bPref { u32x4 vg[4]; u32x2 uu[8]; float s1, s2; };
__device__ __forceinline__ void p2b_load(P2bPref& r, const Params& p, int it, int h, int tid, int wid, int lane, int t, int fq) {
  const bf16_t* VG = (const bf16_t*)(p.ws + WS_VG); const bf16_t* U = (const bf16_t*)(p.ws + WS_U); const float* VST = (const float*)(p.ws + WS_VST);
  const int t0 = (it >> 2) * 128;
#pragma unroll
  for (int i = 0; i < 4; ++i) { int ps, pe; tr_piece(wid + 8 * i, lane, ps, pe); r.vg[i] = __builtin_nontemporal_load((const u32x4*)(VG + (size_t)(t0 + ps) * 512 + h * 128 + pe)); }
#pragma unroll
  for (int nb = 0; nb < 8; ++nb) r.uu[nb] = __builtin_nontemporal_load((const u32x2*)(U + (size_t)(t0 + t) * 512 + h * 128 + 16 * nb + 4 * fq));
  r.s1 = 0.f; r.s2 = 0.f;
  if (tid < 128) {
#pragma unroll
    for (int j = 0; j < 8; ++j) { r.s1 += VST[(size_t)(2 * j) * T + t0 + tid]; r.s2 += VST[(size_t)(2 * j + 1) * T + t0 + tid]; } }
}
__device__ __forceinline__ void p2b_run(LAS unsigned char* lds, const Params& p, int it0, int stride, int nmax) {
  if (it0 >= nmax) return;
  const int tid = opaque_tid(), wid = __builtin_amdgcn_readfirstlane(tid >> 6), lane = tid & 63, fr = lane & 15, fq = lane >> 4;
  LAS bf16_t* vnt = (LAS bf16_t*)lds; LAS float* st = (LAS float*)(lds + 34816);
  bf16_t* MIX = (bf16_t*)(p.ws + WS_MIX);
  const int h = it0 & 3, t = 16 * wid + fr;
  P2bPref r; p2b_load(r, p, it0, h, tid, wid, lane, t, fq);
  bf16x8 A[4];
#pragma unroll
  for (int ks = 0; ks < 4; ++ks) { float a[8];
#pragma unroll
    for (int j = 0; j < 8; ++j) a[j] = 0.f;
    if (32 * ks <= 16 * wid + 15) { const int s0 = 32 * ks + 8 * fq; const float* wp = p.w_s + (size_t)(h * 128 + t) * 128 + s0;
      const f32x4 w0 = *(const f32x4*)wp, w1 = *(const f32x4*)(wp + 4);
#pragma unroll
      for (int j = 0; j < 4; ++j) { a[j] = (s0 + j <= t) ? w0[j] : 0.f; a[4 + j] = (s0 + 4 + j <= t) ? w1[j] : 0.f; } }
    A[ks] = pack8(a); }
  const float bias = p.b_s[h * 128 + t];
  int e8c; { int ps0; tr_piece(wid, lane, ps0, e8c); }
  const f32x4 g0 = *(const f32x4*)(p.lng + h * 128 + e8c), g1 = *(const f32x4*)(p.lng + h * 128 + e8c + 4), b0 = *(const f32x4*)(p.lnb + h * 128 + e8c), b1 = *(const f32x4*)(p.lnb + h * 128 + e8c + 4);
  for (int it = it0; it < nmax; it += stride) {
    const int ti = it >> 2, t0 = ti * 128; const bool open = (ti & 15) == 15;
    if (tid < 128) { const float mu = r.s1 * (1.f / 512.f); const float var = fmaxf(r.s2 * (1.f / 512.f) - mu * mu, 0.f); st[2 * tid] = mu; st[2 * tid + 1] = rsqrtf(var + EPS); }
    u32x4 cvg[4]; u32x2 cuu[8];
#pragma unroll
    for (int i = 0; i < 4; ++i) cvg[i] = r.vg[i];
#pragma unroll
    for (int nb = 0; nb < 8; ++nb) cuu[nb] = r.uu[nb];
    __syncthreads();
    if (it + stride < nmax) p2b_load(r, p, it + stride, h, tid, wid, lane, t, fq);
    float* vout = p.out + O_VP + (size_t)(ti >> 4) * 128 * 512;
#pragma unroll
    for (int i = 0; i < 4; ++i) { int s, e8; tr_piece(wid + 8 * i, lane, s, e8); float a[8]; unpack8(cvg[i], a);
      const float mu = st[2 * s], rs = st[2 * s + 1]; float vn[8];
#pragma unroll
      for (int j = 0; j < 4; ++j) { vn[j] = (a[j] - mu) * rs * g0[j] + b0[j]; vn[4 + j] = (a[4 + j] - mu) * rs * g1[j] + b1[j]; }
      const u32x4 pk = {pack2(vn[0], vn[1]), pack2(vn[2], vn[3]), pack2(vn[4], vn[5]), pack2(vn[6], vn[7])};
      tr_write8(vnt, 136, e8, s, pk);
      if (open) { float* o = vout + (size_t)s * 512 + h * 128 + e8; *(f32x4*)o = (f32x4){vn[0], vn[1], vn[2], vn[3]}; *(f32x4*)(o + 4) = (f32x4){vn[4], vn[5], vn[6], vn[7]}; } }
    __syncthreads();
#pragma unroll
    for (int nb = 0; nb < 8; ++nb) { f32x4 acc = {0.f, 0.f, 0.f, 0.f};
#pragma unroll
      for (int ks = 0; ks < 4; ++ks) if (32 * ks <= 16 * wid + 15) { const bf16x8 B = tr_read8(vnt, 136, 16 * nb + fr, 32 * ks + 8 * fq); acc = __builtin_amdgcn_mfma_f32_16x16x32_bf16(B, A[ks], acc, 0, 0, 0); }
      const int e = 16 * nb + 4 * fq;
      const float o0 = (acc[0] + bias) * bf_lo(cuu[nb][0]), o1 = (acc[1] + bias) * bf_hi(cuu[nb][0]);
      const float o2 = (acc[2] + bias) * bf_lo(cuu[nb][1]), o3 = (acc[3] + bias) * bf_hi(cuu[nb][1]);
      const unsigned long long pk = (unsigned long long)pack2(o0, o1) | ((unsigned long long)pack2(o2, o3) << 32);
      __hip_atomic_store((unsigned long long*)(MIX + (size_t)(t0 + t) * DM + 512 + h * 128 + e), pk, __ATOMIC_RELAXED, __HIP_MEMORY_SCOPE_AGENT); }
    asm volatile("s_waitcnt vmcnt(0)" ::: "memory");
    __syncthreads();
    if (tid == 0) (void)__hip_atomic_fetch_add((unsigned*)(p.ws + WS_BAR) + RDY_OFF + (size_t)(ti >> 1) * RDY_STRIDE, 1u, __ATOMIC_RELAXED, __HIP_MEMORY_SCOPE_AGENT);
  }
}

__device__ __forceinline__ void p2c_item(LAS unsigned char* lds, const Params& p, int n, int h) {
  const int tid = opaque_tid(), wid = tid >> 6, lane = tid & 63;
  LAS float* qs = (LAS float*)lds; LAS float* fs = qs + 1024; LAS float* ks_ = qs + 2048; LAS float* vs = qs + 3072; LAS float* opart = qs + 4096;
  const float* LF = (const float*)(p.ws + WS_LF); const bf16_t* Q = (const bf16_t*)(p.ws + WS_Q); const bf16_t* VI = (const bf16_t*)(p.ws + WS_VI); const bf16_t* ZA = (const bf16_t*)(p.ws + WS_ZA); bf16_t* MIX = (bf16_t*)(p.ws + WS_MIX);
  const int t0 = TP + n * 8;
#pragma unroll
  for (int i = 0; i < 2; ++i) { const int idx = tid + 512 * i, t = idx >> 7, kk = idx & 127; const size_t g = (size_t)(t0 + t) * 512 + h * 128 + kk;
    const float f = __builtin_amdgcn_exp2f((float)((const _Float16*)LF)[g]); fs[idx] = f; ks_[idx] = 1.f - f; qs[idx] = bf2f(Q[g]); vs[idx] = bf2f(VI[g]); }
  const int e = tid & 127, kq = __builtin_amdgcn_readfirstlane(tid >> 7);
  const size_t sbase = ((size_t)(n * 4 + h) * 128 + kq * 32) * 128 + e;
  float S[32];
#pragma unroll
  for (int i = 0; i < 32; ++i) S[i] = __builtin_nontemporal_load(p.st0 + sbase + (size_t)i * 128);
  __syncthreads();
#pragma unroll 1
  for (int t = 0; t < 8; ++t) { const float v = vs[t * 128 + e]; float po = 0.f;
#pragma unroll
    for (int i = 0; i < 32; ++i) { const int kk = kq * 32 + i; S[i] = fs[t * 128 + kk] * S[i] + ks_[t * 128 + kk] * v; po += qs[t * 128 + kk] * S[i]; }
    opart[(kq * 8 + t) * 128 + e] = po; }
  float* so = p.out + O_SS;
#pragma unroll
  for (int i = 0; i < 32; ++i) so[sbase + (size_t)i * 128] = S[i];
  __syncthreads();
  { const int t = wid; float o[2]; float ss = 0.f;
#pragma unroll
    for (int hf = 0; hf < 2; ++hf) { const int ee = lane + 64 * hf; o[hf] = opart[(0 * 8 + t) * 128 + ee] + opart[(1 * 8 + t) * 128 + ee] + opart[(2 * 8 + t) * 128 + ee] + opart[(3 * 8 + t) * 128 + ee]; ss += o[hf] * o[hf]; }
#pragma unroll
    for (int of = 32; of >= 1; of >>= 1) ss += __shfl_xor(ss, of);
    const float rs = rsqrtf(ss * (1.f / 128.f) + EPS);
#pragma unroll
    for (int hf = 0; hf < 2; ++hf) { const int ee = lane + 64 * hf; MIX[(size_t)(t0 + t) * DM + h * 128 + ee] = f2bf(o[hf] * rs * p.hgn[h * 128 + ee] * bf2f(ZA[(size_t)(t0 + t) * 512 + h * 128 + ee])); } }
  __syncthreads();
}

__device__ __forceinline__ void scan_phase(const Params& p, int blk, int nblk) {
  const float* __restrict__ DEC = (const float*)(p.ws + WS_DEC); const bf16_t* __restrict__ SL = (const bf16_t*)p.out; bf16_t* __restrict__ SST = (bf16_t*)(p.ws + WS_SST); float* __restrict__ sp = p.out + O_SP;
  const int ntrip = (nblk * 512 >= 131072) ? 1 : ((blk >= 48 && blk < 48 + (131072 - nblk * 512 + 511) / 512) ? 2 : 1);
  for (int trip = 0; trip < ntrip; ++trip) { const int idx = trip == 0 ? blk * 512 + opaque_tid() : nblk * 512 + (blk - 48) * 512 + opaque_tid(); if (idx >= 131072) continue;
    const int bh = idx >> 12, r = idx & 4095, kk = r >> 5, e4 = (r & 31) * 4;
    const size_t off0 = ((size_t)(bh * 32) * 128 + kk) * 128 + e4;
    const float* dp = DEC + (size_t)bh * 32 * 128 + kk;
    f32x4 S = {0.f, 0.f, 0.f, 0.f};
    u32x2 sl[2][8]; float d[2][8];
#pragma unroll
    for (int j = 0; j < 8; ++j) { sl[0][j] = __builtin_nontemporal_load((const u32x2*)(SL + off0 + (size_t)j * 16384)); d[0][j] = dp[j * 128]; }
#pragma unroll
    for (int k = 0; k < 4; ++k) {
      if (k < 3) {
#pragma unroll
        for (int j = 0; j < 8; ++j) { const int c = 8 * (k + 1) + j; sl[(k + 1) & 1][j] = __builtin_nontemporal_load((const u32x2*)(SL + off0 + (size_t)c * 16384)); d[(k + 1) & 1][j] = dp[c * 128]; }
      }
#pragma unroll
      for (int j = 0; j < 8; ++j) { const int c = 8 * k + j;
        __hip_atomic_store((unsigned long long*)(SST + off0 + (size_t)c * 16384), (unsigned long long)pack2(S[0], S[1]) | ((unsigned long long)pack2(S[2], S[3]) << 32), __ATOMIC_RELAXED, __HIP_MEMORY_SCOPE_AGENT);
        const u32x2 q = sl[k & 1][j]; const f32x4 slv = {bf_lo(q[0]), bf_hi(q[0]), bf_lo(q[1]), bf_hi(q[1])};
        S = S * d[k & 1][j] + slv; }
    }
    *(f32x4*)(sp + ((size_t)bh * 128 + kk) * 128 + e4) = S;
    asm volatile("s_waitcnt vmcnt(0)" ::: "memory");
    __syncthreads();
    if (threadIdx.x == 0) (void)__hip_atomic_fetch_add((unsigned*)(p.ws + WS_BAR) + SCN_OFF + (size_t)bh * SCN_STRIDE, 1u, __ATOMIC_RELAXED, __HIP_MEMORY_SCOPE_AGENT);
  }
}
__device__ __forceinline__ void p4_wait(const Params& p, int it) {
  if (threadIdx.x == 0) { const unsigned* c = (const unsigned*)(p.ws + WS_BAR) + SCN_OFF + (size_t)((it >> 7) * 4 + (it & 3)) * SCN_STRIDE; unsigned sp_ = 0u;
    while (__hip_atomic_load(c, __ATOMIC_RELAXED, __HIP_MEMORY_SCOPE_AGENT) < 8u) { __builtin_amdgcn_s_sleep(2); if (++sp_ > (1u << 21)) break; }
    __builtin_amdgcn_fence(__ATOMIC_ACQUIRE, "agent");
    asm volatile("s_waitcnt vmcnt(0)" ::: "memory"); }
}

struct P4Pref { u32x2 lv[4]; u32x4 vv[2], qq[2], sv[4]; };
__device__ __forceinline__ void p4_load(P4Pref& r, const Params& p, int it) {
  const int tid = opaque_tid(), wid = __builtin_amdgcn_readfirstlane(tid >> 6), lane = tid & 63;
  const int b = it >> 7, c = (it >> 2) & 31, h = it & 3, t0 = b * 2048 + c * 64, slot = (b * 4 + h) * 32 + c;
  const float* LF = (const float*)(p.ws + WS_LF); const bf16_t* VI = (const bf16_t*)(p.ws + WS_VI); const bf16_t* Q = (const bf16_t*)(p.ws + WS_Q); const bf16_t* SST = (const bf16_t*)(p.ws + WS_SST);
#pragma unroll
  for (int i = 0; i < 4; ++i) { const int idx = tid + 512 * i, s = idx >> 5, c4 = idx & 31; r.lv[i] = __builtin_nontemporal_load((const u32x2*)((const _Float16*)LF + (size_t)(t0 + s) * 512 + h * 128 + c4 * 4)); }
#pragma unroll
  for (int i = 0; i < 2; ++i) { int vs, ve; tr_piece(wid + 8 * i, lane, vs, ve); const size_t g = (size_t)(t0 + vs) * 512 + h * 128 + ve; r.vv[i] = __builtin_nontemporal_load((const u32x4*)(VI + g)); r.qq[i] = __builtin_nontemporal_load((const u32x4*)(Q + g)); }
#pragma unroll
  for (int i = 0; i < 4; ++i) { int sk, se; tr_piece(wid + 8 * i, lane, sk, se); r.sv[i] = __builtin_nontemporal_load((const u32x4*)(SST + ((size_t)slot * 128 + sk) * 128 + se)); }
}
__device__ __forceinline__ void p4_item(LAS unsigned char* lds, const Params& p, int b, int c, int h, P4Pref& r, int nxt) {
  const int tid = opaque_tid(), wid = __builtin_amdgcn_readfirstlane(tid >> 6), lane = tid & 63, fr = lane & 15, fq = lane >> 4;
  LAS float* bL = (LAS float*)lds; LAS bf16_t* Vt = (LAS bf16_t*)(lds + 33792); LAS bf16_t* Kb = (LAS bf16_t*)(lds + 52224); LAS bf16_t* Qb = (LAS bf16_t*)(lds + 69632);
  LAS bf16_t* P = (LAS bf16_t*)(lds + 87040); LAS float* tot = (LAS float*)(lds + 96256); LAS bf16_t* StT = (LAS bf16_t*)(lds + 98304); LAS float* ssq = (LAS float*)(lds + 133120);
  const float* LF = (const float*)(p.ws + WS_LF); const bf16_t* VI = (const bf16_t*)(p.ws + WS_VI); const bf16_t* Q = (const bf16_t*)(p.ws + WS_Q); const bf16_t* ZA = (const bf16_t*)(p.ws + WS_ZA);
  const bf16_t* SST = (const bf16_t*)(p.ws + WS_SST); bf16_t* MIX = (bf16_t*)(p.ws + WS_MIX);
  const int t0 = b * 2048 + c * 64, slot = (b * 4 + h) * 32 + c;
  const int mb = wid & 3, nb0 = (wid >> 2) * 4; const int t = 16 * mb + fr;
  u32x2 zq[4]; f32x4 hq[4];
#pragma unroll
  for (int nbi = 0; nbi < 4; ++nbi) { const int e = 16 * (nb0 + nbi) + 4 * fq; hq[nbi] = *(const f32x4*)(p.hgn + h * 128 + e); zq[nbi] = __builtin_nontemporal_load((const u32x2*)(ZA + (size_t)(t0 + t) * 512 + h * 128 + e)); }
#pragma unroll
  for (int i = 0; i < 4; ++i) { const int idx = tid + 512 * i, s = idx >> 5, c4 = idx & 31; *(LAS f32x4*)(bL + s * 132 + c4 * 4) = unpack4h(r.lv[i]); }
#pragma unroll
  for (int i = 0; i < 2; ++i) { int vs, ve; tr_piece(wid + 8 * i, lane, vs, ve); tr_write8(Vt, 72, ve, vs, r.vv[i]); *(LAS u32x4*)(Qb + vs * 136 + ve) = r.qq[i]; }
#pragma unroll
  for (int i = 0; i < 4; ++i) { int sk, se; tr_piece(wid + 8 * i, lane, sk, se); tr_write8(StT, 136, se, sk, r.sv[i]); }
  for (int i = tid; i < 576; i += 512) *(LAS u32x4*)(P + i * 8) = (u32x4){0u, 0u, 0u, 0u};
  if (nxt < 1024) p4_wait(p, nxt);
  __syncthreads();
  if (nxt < 1024) p4_load(r, p, nxt);
  { const int kk = tid & 127, jq = tid >> 7; float run = 0.f;
#pragma unroll
    for (int i = 0; i < 16; ++i) { const int s = 16 * jq + i; const float lf = bL[s * 132 + kk]; const float kv = 1.f - __builtin_amdgcn_exp2f(lf); run += lf;
      const float qv = bf2f(Qb[s * 136 + kk]); Qb[s * 136 + kk] = f2bf(qv * __builtin_amdgcn_exp2f(run)); Kb[s * 136 + kk] = f2bf(kv * __builtin_amdgcn_exp2f(-run)); }
    tot[jq * 128 + kk] = run; }
  __syncthreads();
  { const int ntask = wid < 6 ? 1 : 2;
    for (int q2 = 0; q2 < ntask; ++q2) {
      int I, J;
      if (wid < 6) { I = wid >= 3 ? 3 : wid >= 1 ? 2 : 1; J = wid - (wid >= 3 ? 3 : wid >= 1 ? 1 : 0); }
      else { I = (wid - 6) * 2 + q2; J = I; }
      f32x4 acc = {0.f, 0.f, 0.f, 0.f};
#pragma unroll
      for (int ks = 0; ks < 4; ++ks) { const int kk0 = 32 * ks + 8 * fq;
        const bf16x8 A = *(const LAS bf16x8*)(Qb + (16 * I + fr) * 136 + kk0);
        bf16x8 B = *(const LAS bf16x8*)(Kb + (16 * J + fr) * 136 + kk0);
        if (J < I) { float kv[8], bb[8]; unpack8(__builtin_bit_cast(u32x4, B), kv);
          f32x4 d0 = {0.f, 0.f, 0.f, 0.f}, d1 = {0.f, 0.f, 0.f, 0.f};
          for (int j2 = J; j2 < I; ++j2) { d0 += *(const LAS f32x4*)(tot + j2 * 128 + kk0); d1 += *(const LAS f32x4*)(tot + j2 * 128 + kk0 + 4); }
#pragma unroll
          for (int j = 0; j < 4; ++j) { bb[j] = kv[j] * __builtin_amdgcn_exp2f(d0[j]); bb[4 + j] = kv[4 + j] * __builtin_amdgcn_exp2f(d1[j]); }
          B = pack8(bb); }
        acc = __builtin_amdgcn_mfma_f32_16x16x32_bf16(A, B, acc, 0, 0, 0); }
#pragma unroll
      for (int rg = 0; rg < 4; ++rg) { const int tl = 4 * fq + rg; const float v = (J == I && fr > tl) ? 0.f : acc[rg]; P[(16 * I + tl) * 72 + 16 * J + fr] = f2bf(v); }
    } }
  __syncthreads();
  bf16x8 AP[2], AQ[4];
#pragma unroll
  for (int ks = 0; ks < 2; ++ks) AP[ks] = *(const LAS bf16x8*)(P + t * 72 + 32 * ks + 8 * fq);
#pragma unroll
  for (int ks = 0; ks < 4; ++ks) { const int kk0 = 32 * ks + 8 * fq; float qv[8], a[8]; unpack8(*(const LAS u32x4*)(Qb + t * 136 + kk0), qv);
    f32x4 b0 = {0.f, 0.f, 0.f, 0.f}, b1 = {0.f, 0.f, 0.f, 0.f};
    for (int j2 = 0; j2 < mb; ++j2) { b0 += *(const LAS f32x4*)(tot + j2 * 128 + kk0); b1 += *(const LAS f32x4*)(tot + j2 * 128 + kk0 + 4); }
#pragma unroll
    for (int j = 0; j < 4; ++j) { a[j] = qv[j] * __builtin_amdgcn_exp2f(b0[j]); a[4 + j] = qv[4 + j] * __builtin_amdgcn_exp2f(b1[j]); }
    AQ[ks] = pack8(a); }
  f32x4 o[4]; float ss = 0.f;
#pragma unroll
  for (int nbi = 0; nbi < 4; ++nbi) { const int nb = nb0 + nbi; f32x4 acc = {0.f, 0.f, 0.f, 0.f};
#pragma unroll
    for (int ks = 0; ks < 2; ++ks) { const bf16x8 B = tr_read8(Vt, 72, 16 * nb + fr, 32 * ks + 8 * fq); acc = __builtin_amdgcn_mfma_f32_16x16x32_bf16(B, AP[ks], acc, 0, 0, 0); }
#pragma unroll
    for (int ks = 0; ks < 4; ++ks) { const bf16x8 B = tr_read8(StT, 136, 16 * nb + fr, 32 * ks + 8 * fq); acc = __builtin_amdgcn_mfma_f32_16x16x32_bf16(B, AQ[ks], acc, 0, 0, 0); }
    o[nbi] = acc; ss += acc[0] * acc[0] + acc[1] * acc[1] + acc[2] * acc[2] + acc[3] * acc[3]; }
  ss += __shfl_xor(ss, 16); ss += __shfl_xor(ss, 32);
  if (fq == 0) ssq[(wid >> 2) * 64 + t] = ss;
  __syncthreads();
  const float rs = rsqrtf((ssq[t] + ssq[64 + t]) * (1.f / 128.f) + EPS);
#pragma unroll
  for (int nbi = 0; nbi < 4; ++nbi) { const int e = 16 * (nb0 + nbi) + 4 * fq; const f32x4 hg = hq[nbi];
    const u32x2 zz = zq[nbi];
    const float o0 = o[nbi][0] * rs * hg[0] * bf_lo(zz[0]), o1 = o[nbi][1] * rs * hg[1] * bf_hi(zz[0]), o2 = o[nbi][2] * rs * hg[2] * bf_lo(zz[1]), o3 = o[nbi][3] * rs * hg[3] * bf_hi(zz[1]);
    const unsigned long long pk = (unsigned long long)pack2(o0, o1) | ((unsigned long long)pack2(o2, o3) << 32);
    __hip_atomic_store((unsigned long long*)(MIX + (size_t)(t0 + t) * DM + h * 128 + e), pk, __ATOMIC_RELAXED, __HIP_MEMORY_SCOPE_AGENT); }
  asm volatile("s_waitcnt vmcnt(0)" ::: "memory");
  __syncthreads();
  if (tid == 0) (void)__hip_atomic_fetch_add((unsigned*)(p.ws + WS_BAR) + RDY_OFF + (size_t)(t0 >> 8) * RDY_STRIDE, 1u, __ATOMIC_RELAXED, __HIP_MEMORY_SCOPE_AGENT);
}

__device__ __forceinline__ void phase6(const Params& p) {
  const int tid = opaque_tid(), wid = tid >> 6, lane = tid & 63;
  const float* RSP = (const float*)(p.ws + WS_RSP); float* y = p.out + O_Y;
  for (int r = blockIdx.x * 8 + wid; r < T; r += gridDim.x * 8) {
    float ss = RSP[(size_t)(lane & 15) * T + r];
#pragma unroll
    for (int o = 8; o >= 1; o >>= 1) ss += __shfl_xor(ss, o);
    const float rs = rsqrtf(ss * (1.f / DM) + EPS);
#pragma unroll
    for (int j = 0; j < 4; ++j) { float* yp = y + (size_t)r * DM + j * 256 + lane * 4; const f32x4 g = *(const f32x4*)(p.fng + j * 256 + lane * 4); f32x4 v = *(const f32x4*)yp; v = v * g * rs; *(f32x4*)yp = v; }
  }
}

__global__ void __launch_bounds__(512, 2) fwd_mega(Params p) {
  cg::grid_group grid = cg::this_grid();
  extern __shared__ __attribute__((aligned(16))) unsigned char shm[];
  LAS unsigned char* lds = (LAS unsigned char*)shm;
  const int G = (int)gridDim.x, blk = (int)blockIdx.x;
  volatile LAS unsigned* xst = (volatile LAS unsigned*)(lds + LDS_ST_OFF);
  if (threadIdx.x == 0) { xst[0] = 0u; xst[1] = 0u; xst[2] = 0u; xst[3] = 0u; }
  __syncthreads();
  const XcdBarrier xb = xcd_barrier_post((unsigned*)(p.ws + WS_BAR), xst);
#define GRID_SYNC() do { if (p.use_cg) grid.sync(); else xcd_barrier(xb); } while (0)

  for (int rep = 0; rep < R0; ++rep) phase0(lds, p);
  GRID_SYNC();

  { Gemm g{(const bf16_t*)(p.ws + WS_XB), (const bf16_t*)(p.ws + WS_WINT), T, DIN, DM}; StaticOrder S; S.init(T, DIN, G, blk);
    Epi1 E{(const float*)(p.ws + WS_RN), p.lbl, (bf16_t*)(p.ws + WS_Q), (bf16_t*)(p.ws + WS_VI), (bf16_t*)(p.ws + WS_ZA), (bf16_t*)(p.ws + WS_U), (bf16_t*)(p.ws + WS_VG), (bf16_t*)(p.ws + WS_ZB), (float*)(p.ws + WS_LF), (float*)(p.ws + WS_VST)};
    gemm_phase(lds, g, S, E); }
  { const int nfull = (T / BM) * (DIN / BM) - 3 * G;
    if (blk >= nfull && nfull > 0 && nfull < G) { const int j = blk - nfull, nj = G - nfull;
      wtiles(lds, p, 896, 896 + 256, j, nj);
      float acc_ = 0.f;
      for (size_t l = (size_t)j * 512 + opaque_tid(); l < (size_t)128 * 4 * 16384 / 32; l += (size_t)nj * 512) acc_ += p.st0[l * 32];
      if (acc_ == 12345.678f) ((float*)(p.ws + WS_RN))[0] = acc_; } }
  GRID_SYNC();

  {
    const bool giver = (blk >= 32 && blk < 64) && G == 256, taker = G == 256 && blk >= 64 && ((blk - 64) % 6 == 0) && ((blk - 64) / 6 < 32);
    const int nit = G == 256 ? (giver ? 3 : (taker ? 5 : 4)) : (1024 - blk + G - 1) / G;
    P2aPref r; if (nit > 0) p2a_load(r, p, blk);
    for (int k = 0; k < nit; ++k) { const int id = k < 4 || G != 256 ? blk + G * k : 32 + (blk - 64) / 6 + 768;
      const int k1 = k + 1; const int nx = k1 < nit ? ((k1 < 4 || G != 256) ? blk + G * k1 : 32 + (blk - 64) / 6 + 768) : 1024;
      p2a_item(lds, p, id >> 7, (id >> 2) & 31, id & 3, r, nx); } }
  if (blk < 32) { p2b_item(lds, p, 128 + (blk >> 2), blk & 3); p2c_item(lds, p, blk >> 2, blk & 3); }
  else { for (int j = blk; j < 512; j += G - 32) p2c_item(lds, p, j >> 2, j & 3); }
  GRID_SYNC();

  if (blk < NG2) {
    Gemm g{(const bf16_t*)(p.ws + WS_MIX) + (size_t)TP * DM, (const bf16_t*)(p.ws + WS_WOUTT), T - TP, DM, DM}; StaticOrder S; S.init(T - TP, DM, NG2, blk);
    Epi2 E{(const bf16_t*)(p.ws + WS_XB), p.fng, p.out + O_Y, (float*)(p.ws + WS_RSP), (unsigned*)(p.ws + WS_BAR) + XCD_BAR_WORDS_C, TP, (const float*)(p.ws + WS_RN)};
    gemm_phase(lds, g, S, E);
  } else {
    for (int rep = 0; rep < R3; ++rep) scan_phase(p, blk - NG2, G - NG2);
    p2b_run(lds, p, blk - NG2, G - NG2, 512);
  }
  float pf_acc = 0.f;
  { StaticOrder S; S.init(TP, DM, G, blk); Unit u;
    if (S.next(0, u)) {
#pragma unroll
      for (int i = 0; i < 2; ++i) { const int l = opaque_tid() + 512 * i; pf_acc += (float)((const bf16_t*)(p.ws + WS_XB))[(size_t)(u.pm * BM + (l >> 2)) * DM + u.pn * BM + (l & 3) * 64]; } } }
  { P4Pref r; int i4 = blk; if (i4 < 1024) { p4_wait(p, i4); __syncthreads(); p4_load(r, p, i4); }
    for (; i4 < 1024; i4 += G) p4_item(lds, p, i4 >> 7, (i4 >> 2) & 31, i4 & 3, r, i4 + G); }
  if (pf_acc == 12345.678f) ((float*)(p.ws + WS_BAR))[8] = pf_acc;

  { Gemm g{(const bf16_t*)(p.ws + WS_MIX), (const bf16_t*)(p.ws + WS_WOUTT), TP, DM, DM}; StaticOrder S; S.init(TP, DM, G, blk);
    Epi2 E{(const bf16_t*)(p.ws + WS_XB), p.fng, p.out + O_Y, (float*)(p.ws + WS_RSP), (unsigned*)(p.ws + WS_BAR) + XCD_BAR_WORDS_C, 0, (const float*)(p.ws + WS_RN)};
    gemm_phase(lds, g, S, E, (const unsigned*)(p.ws + WS_BAR) + RDY_OFF, 24u); }
}

extern "C" void kernel_launch(void* const* d_in, const int* in_sizes, int n_in, void* d_out, int out_size,
                              void* d_ws, size_t ws_size, hipStream_t stream) {
  static int grid_blocks = 0;
  if (!grid_blocks) {
    int dev = 0, cus = 0, per_cu = 0;
    (void)hipGetDevice(&dev);
    (void)hipDeviceGetAttribute(&cus, hipDeviceAttributeMultiprocessorCount, dev);
    (void)hipFuncSetAttribute((const void*)fwd_mega, hipFuncAttributeMaxDynamicSharedMemorySize, LDS_BYTES);
    (void)hipOccupancyMaxActiveBlocksPerMultiprocessor(&per_cu, (const void*)fwd_mega, 512, LDS_BYTES);
    if (cus < 32) cus = 256;
    grid_blocks = 256;
    if (ws_size < WS_END) fprintf(stderr, "kernel_launch: workspace too small (%zu < %zu)\n", ws_size, (size_t)WS_END);
  }
  Params p{};
  p.xp = (const float*)d_in[0]; p.xs = (const float*)d_in[1]; p.st0 = (const float*)d_in[2]; p.norm_g = (const float*)d_in[3]; p.w_in = (const float*)d_in[4];
  p.lbl = (const float*)d_in[5]; p.hgn = (const float*)d_in[6]; p.lng = (const float*)d_in[7]; p.lnb = (const float*)d_in[8]; p.w_s = (const float*)d_in[9];
  p.b_s = (const float*)d_in[10]; p.w_out = (const float*)d_in[11]; p.fng = (const float*)d_in[12];
  p.out = (float*)d_out; p.ws = (unsigned char*)d_ws;
  p.use_cg = 0; p.pad = 0;
  (void)hipMemsetAsync((unsigned char*)d_ws + WS_BAR, 0, BAR_BYTES, stream);
  void* args[] = {&p};
  hipError_t e = hipLaunchCooperativeKernel((const void*)fwd_mega, dim3(grid_blocks), dim3(512), args, LDS_BYTES, stream);
  if (e != hipSuccess) fprintf(stderr, "cooperative launch failed: %s (grid %d)\n", hipGetErrorString(e), grid_blocks);
}
```

```cpp
#include <hip/hip_runtime.h>
#include <hip/hip_cooperative_groups.h>
#include <cstdio>
namespace cg = cooperative_groups;

#define LAS __attribute__((address_space(3)))
typedef unsigned short bf16_t;
typedef short bf16x8 __attribute__((ext_vector_type(8)));
typedef float f32x4 __attribute__((ext_vector_type(4)));
typedef float f32x2 __attribute__((ext_vector_type(2)));
typedef __bf16 bf16x2_t __attribute__((ext_vector_type(2)));
typedef unsigned u32x4 __attribute__((ext_vector_type(4)));
typedef unsigned u32x2 __attribute__((ext_vector_type(2)));
typedef _Float16 f16x2_t __attribute__((ext_vector_type(2)));

constexpr int T = 17408, TP = 16384, DM = 1024, DIN = 3584;
constexpr float EPS = 1e-6f;
constexpr int LDS_BYTES = 134144;
constexpr int R0 = 1, R2 = 1, R3 = 1, R4 = 1;
constexpr int NG2 = 16;
constexpr int XCD_BAR_WORDS_C = 3456;
constexpr int LDS_ST_OFF = 134128;

constexpr size_t WS_XB = 0;
constexpr size_t WS_RN = WS_XB + (size_t)T * DM * 2;
constexpr size_t WS_RSP = WS_RN + (size_t)T * 4;
constexpr size_t WS_WINT = WS_RSP + (size_t)16 * T * 4;
constexpr size_t WS_WOUTT = WS_WINT + (size_t)DIN * DM * 2;
constexpr size_t WS_Q = WS_WOUTT + (size_t)DM * DM * 2;
constexpr size_t WS_VI = WS_Q + (size_t)T * 512 * 2;
constexpr size_t WS_ZA = WS_VI + (size_t)T * 512 * 2;
constexpr size_t WS_U = WS_ZA + (size_t)T * 512 * 2;
constexpr size_t WS_VG = WS_U + (size_t)T * 512 * 2;
constexpr size_t WS_ZB = WS_VG + (size_t)T * 512 * 2;
constexpr size_t WS_LF = WS_ZB + (size_t)T * 512 * 2;
constexpr size_t WS_DEC = WS_LF + (size_t)T * 512 * 4;
constexpr size_t WS_SST = WS_DEC + (size_t)1024 * 128 * 4;
constexpr size_t WS_MIX = WS_SST + (size_t)1024 * 128 * 128 * 2;
constexpr size_t WS_VST = WS_MIX + (size_t)T * DM * 2;
constexpr size_t WS_BAR = WS_VST + (size_t)16 * T * 4;
constexpr int PC_STRIDE = 64;
constexpr int SCN_OFF = XCD_BAR_WORDS_C + 68 * PC_STRIDE, SCN_STRIDE = 16;
constexpr int RDY_OFF = XCD_BAR_WORDS_C + 68 * PC_STRIDE + 32 * 16, RDY_STRIDE = 16;
constexpr size_t BAR_BYTES = (size_t)(XCD_BAR_WORDS_C + 68 * PC_STRIDE + 32 * 16 + 64 * 16) * 4;
constexpr size_t WS_END = WS_BAR + BAR_BYTES;

constexpr size_t O_Y = 0;
constexpr size_t O_SP = (size_t)T * DM;
constexpr size_t O_SS = O_SP + 524288;
constexpr size_t O_VP = O_SS + 8388608;
constexpr size_t O_VS = O_VP + 524288;

struct Params {
  const float* xp; const float* xs; const float* st0; const float* norm_g; const float* w_in; const float* lbl;
  const float* hgn; const float* lng; const float* lnb; const float* w_s; const float* b_s; const float* w_out; const float* fng;
  float* out; unsigned char* ws; int use_cg; int pad;
};

__device__ __forceinline__ int opaque_tid() { int t = threadIdx.x; asm volatile("" : "+v"(t)); return t; }
__device__ __forceinline__ float bf_lo(unsigned u) { return __uint_as_float(u << 16); }
__device__ __forceinline__ float bf_hi(unsigned u) { return __uint_as_float(u & 0xffff0000u); }
__device__ __forceinline__ float bf2f(bf16_t b) { return __uint_as_float(((unsigned)b) << 16); }
__device__ __forceinline__ unsigned pack2(float lo, float hi) { f32x2 v = {lo, hi}; bf16x2_t b = __builtin_convertvector(v, bf16x2_t); return __builtin_bit_cast(unsigned, b); }
__device__ __forceinline__ bf16_t f2bf(float f) { return (bf16_t)(pack2(f, 0.f) & 0xffffu); }
__device__ __forceinline__ unsigned pack2h(float lo, float hi) { f32x2 v = {lo, hi}; f16x2_t b = __builtin_convertvector(v, f16x2_t); return __builtin_bit_cast(unsigned, b); }
typedef _Float16 f16x4_t __attribute__((ext_vector_type(4)));
__device__ __forceinline__ f32x4 unpack4h(u32x2 u) { const f16x4_t h = __builtin_bit_cast(f16x4_t, u); return __builtin_convertvector(h, f32x4); }
__device__ __forceinline__ float fsigmoid(float x) { return __builtin_amdgcn_rcpf(1.f + __expf(-x)); }
__device__ __forceinline__ bf16x8 pack8(const float (&a)[8]) {
  u32x4 u = {pack2(a[0], a[1]), pack2(a[2], a[3]), pack2(a[4], a[5]), pack2(a[6], a[7])};
  return __builtin_bit_cast(bf16x8, u);
}
__device__ __forceinline__ void unpack8(u32x4 u, float (&a)[8]) {
#pragma unroll
  for (int j = 0; j < 4; ++j) { a[2 * j] = bf_lo(u[j]); a[2 * j + 1] = bf_hi(u[j]); }
}


#define XB_TMO      128
#define XB_XCNT(j)  (256  + 64 * (j))
#define XB_XSUB(j)  (1280 + 64 * (j))
#define XB_XGEN(j)  (2304 + 64 * (j))
#define XB_TOP      3328
#define XB_TOPGEN   3392
#define XCD_BAR_WORDS 3456
#define XB_SPIN_CAP (1u << 18)
__device__ __forceinline__ unsigned xb_ld(unsigned* p)              { return __hip_atomic_load(p, __ATOMIC_RELAXED, __HIP_MEMORY_SCOPE_AGENT); }
__device__ __forceinline__ unsigned xb_add(unsigned* p, unsigned v) { return __hip_atomic_fetch_add(p, v, __ATOMIC_RELAXED, __HIP_MEMORY_SCOPE_AGENT); }
__device__ __forceinline__ unsigned xb_xcc_id() { return (unsigned)__builtin_amdgcn_s_getreg((3 << 11) | 20) & 0xFu; }
#define XB_SPIN(cond, bar) do { unsigned _sp = 0; while (cond) { __builtin_amdgcn_s_sleep(1); \
    if ((++_sp & 255u) == 0u) { if (xb_ld(&(bar)[XB_TMO])) break; if (_sp > XB_SPIN_CAP) { atomicAdd(&(bar)[XB_TMO], 1u); break; } } } } while (0)
struct XcdBarrier { unsigned* bar; unsigned x; volatile LAS unsigned* st; };
__device__ __forceinline__ XcdBarrier xcd_barrier_post(unsigned* bar, volatile LAS unsigned* st) {
  XcdBarrier b; b.bar = bar; b.x = xb_xcc_id(); b.st = st;
  if (threadIdx.x == 0) (void)xb_add(&bar[XB_XCNT(b.x)], 1u);
  return b;
}
__device__ __forceinline__ void xcd_barrier_complete(unsigned* bar, unsigned x, unsigned& nloc, unsigned& nx) {
  const unsigned G = gridDim.x * gridDim.y * gridDim.z;
  unsigned sum, cnt, mine, sp = 0u;
  for (;;) {
    sum = 0u; cnt = 0u; mine = 0u;
#pragma unroll
    for (unsigned j = 0; j < 16; ++j) { const unsigned c = xb_ld(&bar[XB_XCNT(j)]); sum += c; cnt += (c > 0u) ? 1u : 0u; mine = (j == x) ? c : mine; }
    if (sum == G) break;
    __builtin_amdgcn_s_sleep(1);
    if ((++sp & 255u) == 0u) { if (xb_ld(&bar[XB_TMO])) break; if (sp > XB_SPIN_CAP) { atomicAdd(&bar[XB_TMO], 1u); break; } }
  }
  nloc = mine > 0u ? mine : 1u; nx = cnt > 0u ? cnt : 1u;
}
__device__ __forceinline__ void xcd_barrier(const XcdBarrier& b) {
  asm volatile("s_waitcnt vmcnt(0)" ::: "memory");
  __syncthreads();
  if (threadIdx.x == 0) {
    unsigned* bar = b.bar;
    __builtin_amdgcn_s_waitcnt(0);
    unsigned nloc = b.st[0], nx = b.st[1];
    if (nloc == 0u) { xcd_barrier_complete(bar, b.x, nloc, nx); b.st[0] = nloc; b.st[1] = nx; }
    const unsigned old = xb_add(&bar[XB_XSUB(b.x)], 1u);
    const unsigned gen = old / nloc;
    if (old + 1u == (gen + 1u) * nloc) {
      __builtin_amdgcn_fence(__ATOMIC_RELEASE, "agent");
      asm volatile("s_waitcnt vmcnt(0)" ::: "memory");
      const unsigned og = xb_add(&bar[XB_TOP], 1u);
      const unsigned tg = og / nx;
      if (og + 1u == (tg + 1u) * nx) xb_add(&bar[XB_TOPGEN], 1u);
      else XB_SPIN(xb_ld(&bar[XB_TOPGEN]) == tg, bar);
      __builtin_amdgcn_fence(__ATOMIC_ACQUIRE, "agent");
      xb_add(&bar[XB_XGEN(b.x)], 1u);
      asm volatile("s_waitcnt vmcnt(0)" ::: "memory");
    } else {
      XB_SPIN(xb_ld(&bar[XB_XGEN(b.x)]) == gen, bar);
      __builtin_amdgcn_fence(__ATOMIC_ACQUIRE, "agent");
      asm volatile("s_waitcnt vmcnt(0)" ::: "memory");
    }
  }
  __syncthreads();
}

constexpr int BM = 256, BK = 64, HALF = 128, HTB = HALF * BK * 2, NXCD = 8, WGM = 8;
__device__ __forceinline__ int lds_byte(int r, int c) { const int st = (r >> 4) * 2 + (c >> 5), rr = r & 15, cc = c & 31, ob = rr * 64 + cc * 2; return st * 1024 + (ob ^ (((ob >> 9) & 1) << 5)); }
__device__ __forceinline__ void stage_rc(int b, int& R, int& C) { const int st = b / 1024, sb = b % 1024, swz = sb ^ (((sb >> 9) & 1) << 5); R = (st >> 1) * 16 + swz / 64; C = (st & 1) * 32 + (swz % 64) / 2; }
struct Unit { int pm, pn; };
struct Gemm { const bf16_t* A; const bf16_t* Bt; int M, N, K; };
struct StaticOrder {
  int nM, nN, nwg, G, c;
  __device__ void init(int M, int N, int G_, int c_) { nM = M / BM; nN = N / BM; nwg = nM * nN; G = G_; c = c_; }
  __device__ bool next(int i, Unit& u) const {
    const long L = (long)i * G + c; if (L >= nwg) return false;
    int wgid = (int)L; { const int q = nwg / NXCD, r = nwg % NXCD, xcd = wgid % NXCD, off = wgid / NXCD; wgid = (xcd < r ? xcd * (q + 1) : r * (q + 1) + (xcd - r) * q) + off; }
    const int nig = WGM * nN, gid = wgid / nig, fm = gid * WGM, gsz = (nM - fm) < WGM ? (nM - fm) : WGM;
    u.pm = fm + ((wgid % nig) % gsz); u.pn = (wgid % nig) / gsz; return true;
  }
};

template <class Epi>
__device__ __forceinline__ void gemm_phase(LAS unsigned char* lds, const Gemm g, const StaticOrder& S, const Epi& E, const unsigned* ready = nullptr, unsigned need = 0u) {
  int tid_ = threadIdx.x; asm volatile("" : "+v"(tid_));
  const int tid = tid_, wid = __builtin_amdgcn_readfirstlane(tid >> 6), lane = tid & 63, wr = wid >> 2, wc = wid & 3, fr = lane & 15, fq = lane >> 4;
  constexpr int K = DM, nt = K / BK;
  unsigned voffA[2], voffB[2];
#pragma unroll
  for (int i = 0; i < 2; ++i) { int R, C; stage_rc(tid * 16 + i * 8192, R, C); const int rho = R & 31, Rb = (R & ~31) + 8 * ((rho & 15) >> 2) + 4 * (rho >> 4) + (rho & 3);
    voffA[i] = (unsigned)(R * K + C) * 2u; voffB[i] = (unsigned)(Rb * K + C) * 2u; }
  const size_t kstep = (size_t)(BK * 2);
  const size_t hstep = (size_t)HALF * K * 2;
  const size_t tstep = 2 * hstep;
  const unsigned ldsw = (unsigned)wid * 1024u;
  const int aoff = lds_byte(wr * 64 + fr, fq * 8), boff = lds_byte(wc * 32 + fr, fq * 8);
#define PG8_SA(b, h) (((b) * 2 + (h)) * HTB)
#define PG8_SB(b, h) ((4 + (b) * 2 + (h)) * HTB)
#define PG8_STAGE(bufoff, gbase, voff) do { _Pragma("unroll") for (int _i = 0; _i < 2; ++_i) \
    __builtin_amdgcn_global_load_lds((const unsigned*)((const char*)(gbase) + (voff)[_i]), (LAS unsigned*)(lds + (bufoff) + ldsw + _i * 8192), 16, 0, 0); } while (0)
#define PG8_LDA(dst, b, h) do { _Pragma("unroll") for (int m = 0; m < 4; ++m) _Pragma("unroll") for (int k = 0; k < 2; ++k) dst[m][k] = *(const LAS bf16x8*)(lds + PG8_SA(b, h) + aoff + m * 2048 + k * 1024); } while (0)
#define PG8_LDB(dst, b, h) do { _Pragma("unroll") for (int n = 0; n < 2; ++n) _Pragma("unroll") for (int k = 0; k < 2; ++k) dst[n][k] = *(const LAS bf16x8*)(lds + PG8_SB(b, h) + boff + n * 2048 + k * 1024); } while (0)
#define PG8_MMA(ai, bj, At, Bt) do { __builtin_amdgcn_s_setprio(1); _Pragma("unroll") for (int m = 0; m < 4; ++m) _Pragma("unroll") for (int n = 0; n < 2; ++n) _Pragma("unroll") for (int k = 0; k < 2; ++k) \
    acc[ai][bj][m][n] = __builtin_amdgcn_mfma_f32_16x16x32_bf16(Bt[n][k], At[m][k], acc[ai][bj][m][n], 0, 0, 0); __builtin_amdgcn_s_setprio(0); } while (0)
#define PG8_WAIT_V(n) asm volatile("s_waitcnt vmcnt(" #n ")" ::: "memory")
#define PG8_WAIT_L(n) asm volatile("s_waitcnt lgkmcnt(" #n ")" ::: "memory")
#define PG8_BAR __builtin_amdgcn_s_barrier()
#define PG8_SCHED __builtin_amdgcn_sched_barrier(0)
  Unit cur, nxt; int ui = 0;
  if (!S.next(0, cur)) return;
  f32x4 acc[2][2][4][2];
#pragma unroll
  for (int a = 0; a < 2; ++a)
#pragma unroll
    for (int b = 0; b < 2; ++b)
#pragma unroll
      for (int m = 0; m < 4; ++m)
#pragma unroll
        for (int n = 0; n < 2; ++n) acc[a][b][m][n] = (f32x4){0.f, 0.f, 0.f, 0.f};
  bf16x8 At[4][2], B0[2][2], B1[2][2];
  const char* cA = (const char*)g.A + (size_t)cur.pm * tstep; const char* cB = (const char*)g.Bt + (size_t)cur.pn * tstep;
  if (ready) {
    if (tid < 64) { unsigned sp = 0u;
      while ((unsigned)__builtin_amdgcn_readfirstlane(__hip_atomic_load(ready + (size_t)cur.pm * RDY_STRIDE, __ATOMIC_RELAXED, __HIP_MEMORY_SCOPE_AGENT)) < need) { __builtin_amdgcn_s_sleep(2); if (++sp > (1u << 21)) break; }
      __builtin_amdgcn_fence(__ATOMIC_ACQUIRE, "agent");
      asm volatile("s_waitcnt vmcnt(0)" ::: "memory"); }
    asm volatile("" ::: "memory"); __builtin_amdgcn_s_barrier(); asm volatile("" ::: "memory"); }
  PG8_STAGE(PG8_SB(0, 0), cB, voffB); PG8_STAGE(PG8_SB(0, 1), cB + hstep, voffB); PG8_STAGE(PG8_SA(0, 0), cA, voffA); PG8_STAGE(PG8_SA(0, 1), cA + hstep, voffA);
  if (wr == 1) PG8_BAR;
  PG8_WAIT_V(2); PG8_BAR;
  PG8_STAGE(PG8_SB(1, 0), cB + kstep, voffB); PG8_STAGE(PG8_SA(1, 0), cA + kstep, voffA); PG8_STAGE(PG8_SB(1, 1), cB + hstep + kstep, voffB);
  PG8_WAIT_V(6); PG8_BAR;
  for (;;) {
    const bool has_next = S.next(ui + 1, nxt);
    const char* nA = has_next ? (const char*)g.A + (size_t)nxt.pm * tstep : cA; const char* nB = has_next ? (const char*)g.Bt + (size_t)nxt.pn * tstep : cB;
    for (int t = 0; t < nt; t += 2) {
      const bool last = (t == nt - 2);
      const char* a1 = cA + (size_t)(t + 1) * kstep;
      const char* a2 = last ? nA : cA + (size_t)(t + 2) * kstep; const char* b2 = last ? nB : cB + (size_t)(t + 2) * kstep;
      const char* a3 = a2 + kstep; const char* b3 = b2 + kstep;
      PG8_LDB(B0, 0, 0); PG8_LDB(B1, 0, 1); PG8_SCHED; PG8_LDA(At, 0, 0); PG8_STAGE(PG8_SA(1, 1), a1 + hstep, voffA);
      PG8_WAIT_V(8); PG8_WAIT_L(0); PG8_BAR; PG8_MMA(0, 0, At, B0); PG8_MMA(0, 1, At, B1); PG8_BAR; PG8_SCHED;
      PG8_LDA(At, 0, 1); PG8_STAGE(PG8_SB(0, 0), b2, voffB); PG8_STAGE(PG8_SB(0, 1), b2 + hstep, voffB); PG8_STAGE(PG8_SA(0, 0), a2, voffA);
      PG8_WAIT_V(8); PG8_WAIT_L(0); PG8_BAR; PG8_MMA(1, 0, At, B0); PG8_MMA(1, 1, At, B1); PG8_BAR; PG8_SCHED;
      PG8_LDB(B0, 1, 0); PG8_LDB(B1, 1, 1); PG8_SCHED; PG8_LDA(At, 1, 0); PG8_STAGE(PG8_SA(0, 1), a2 + hstep, voffA);
      PG8_WAIT_V(8); PG8_WAIT_L(0); PG8_BAR; PG8_MMA(0, 0, At, B0); PG8_MMA(0, 1, At, B1); PG8_BAR; PG8_SCHED;
      PG8_LDA(At, 1, 1); PG8_STAGE(PG8_SB(1, 0), b3, voffB); PG8_STAGE(PG8_SB(1, 1), b3 + hstep, voffB); PG8_STAGE(PG8_SA(1, 0), a3, voffA);
      PG8_WAIT_V(8); PG8_WAIT_L(0); PG8_BAR; PG8_MMA(1, 0, At, B0); PG8_MMA(1, 1, At, B1); PG8_BAR; PG8_SCHED;
    }
    if constexpr (!Epi::AFTER_DRAIN) { if (wr == 0) PG8_BAR;
      E(acc, cur, wr, wc, fr, fq); }
    if (!has_next) break;
#pragma unroll
    for (int a = 0; a < 2; ++a)
#pragma unroll
      for (int b = 0; b < 2; ++b)
#pragma unroll
        for (int m = 0; m < 4; ++m)
#pragma unroll
          for (int n = 0; n < 2; ++n) acc[a][b][m][n] = (f32x4){0.f, 0.f, 0.f, 0.f};
    cur = nxt; cA = nA; cB = nB; ++ui;
    if constexpr (!Epi::AFTER_DRAIN) { if (wr == 1) PG8_BAR; }
  }
  PG8_WAIT_V(0);
  if constexpr (Epi::AFTER_DRAIN) { if (wr == 0) PG8_BAR; }
  PG8_BAR;
  if constexpr (Epi::AFTER_DRAIN) E.fused(acc, cur, wr, wc, fr, fq);
#undef PG8_SA
#undef PG8_SB
#undef PG8_STAGE
#undef PG8_LDA
#undef PG8_LDB
#undef PG8_MMA
#undef PG8_WAIT_V
#undef PG8_WAIT_L
#undef PG8_BAR
#undef PG8_SCHED
}

struct Epi1 {
  static constexpr bool AFTER_DRAIN = false;
  const float* rn; const float* lbl; bf16_t* Q; bf16_t* VI; bf16_t* ZA; bf16_t* U; bf16_t* VG; bf16_t* ZB; float* LF; float* VST;
  __device__ __forceinline__ void operator()(const f32x4 (&acc)[2][2][4][2], const Unit& u, int wr, int wc, int fr, int fq) const {
    const int row0 = u.pm * BM + wr * 64 + fr; const int type = u.pn < 8 ? (u.pn >> 1) : (u.pn < 12 ? 7 : 5);
    const int col0 = (u.pn & 1) * 256 + wc * 32 + 8 * fq;
    float sc[2][4];
#pragma unroll
    for (int ai = 0; ai < 2; ++ai)
#pragma unroll
      for (int m = 0; m < 4; ++m) sc[ai][m] = 1.f;
    if (type == 1) {
      f32x4 lb[2][2];
#pragma unroll
      for (int bj = 0; bj < 2; ++bj)
#pragma unroll
        for (int n = 0; n < 2; ++n) { const int c = col0 + bj * HALF + n * 4; const f32x4 l0 = *(const f32x4*)(lbl + c), l1 = *(const f32x4*)(lbl + 512 + c);
#pragma unroll
          for (int j = 0; j < 4; ++j) lb[bj][n][j] = __builtin_amdgcn_rcpf(1.f + __expf(l1[j] - l0[j])); }
#pragma unroll
      for (int ai = 0; ai < 2; ++ai)
#pragma unroll
        for (int m = 0; m < 4; ++m) { const int r = row0 + ai * HALF + m * 16; const float s = sc[ai][m]; _Float16* rowp = (_Float16*)LF + (size_t)r * 512 + col0;
#pragma unroll
          for (int bj = 0; bj < 2; ++bj) { float o[8];
#pragma unroll
            for (int n = 0; n < 2; ++n)
#pragma unroll
              for (int j = 0; j < 4; ++j) { const float v = acc[ai][bj][m][n][j] * s; const float l = lb[bj][n][j]; o[4 * n + j] = __builtin_amdgcn_logf(l + (1.f - l) * fsigmoid(v)); }
            const u32x4 pk = {pack2h(o[0], o[1]), pack2h(o[2], o[3]), pack2h(o[4], o[5]), pack2h(o[6], o[7])};
            *(u32x4*)(rowp + bj * HALF) = pk; } }
    } else if (type == 7) {
      bf16_t* base = U + (size_t)(u.pn - 8) * 128 + wc * 32 + 8 * fq;
#pragma unroll
      for (int ai = 0; ai < 2; ++ai)
#pragma unroll
        for (int m = 0; m < 4; ++m) { const int r = row0 + ai * HALF + m * 16; const float s = sc[ai][m]; float o[8];
#pragma unroll
          for (int n = 0; n < 2; ++n)
#pragma unroll
            for (int j = 0; j < 4; ++j) { const float uu = acc[ai][0][m][n][j] * s, zz = acc[ai][1][m][n][j] * s;
              const float ea = __expf(-1.5957691216f * (uu + 0.044715f * uu * uu * uu)), eb = __expf(-zz);
              o[4 * n + j] = uu * zz * __builtin_amdgcn_rcpf((1.f + ea) * (1.f + eb)); }
          const u32x4 pk = {pack2(o[0], o[1]), pack2(o[2], o[3]), pack2(o[4], o[5]), pack2(o[6], o[7])};
          *(u32x4*)(base + (size_t)r * 512) = pk; }
    } else {
      bf16_t* base = type == 0 ? Q : type == 2 ? VI : type == 3 ? ZA : VG;
      const int act = (type == 2) ? 0 : (type == 5) ? 2 : 1;
#pragma unroll
      for (int ai = 0; ai < 2; ++ai)
#pragma unroll
        for (int m = 0; m < 4; ++m) { const int r = row0 + ai * HALF + m * 16; const float s = sc[ai][m]; bf16_t* rowp = base + (size_t)r * 512 + col0; float s1 = 0.f, s2 = 0.f;
#pragma unroll
          for (int bj = 0; bj < 2; ++bj) { float o[8];
#pragma unroll
            for (int n = 0; n < 2; ++n)
#pragma unroll
              for (int j = 0; j < 4; ++j) { const float v = acc[ai][bj][m][n][j] * s; const float tt = (act == 2) ? 1.5957691216f * (v + 0.044715f * v * v * v) : v;
                const float sg = fsigmoid(tt); const float ov = (act == 0) ? v : v * sg; o[4 * n + j] = ov; if (type == 5) { s1 += ov; s2 += ov * ov; } }
            const u32x4 pk = {pack2(o[0], o[1]), pack2(o[2], o[3]), pack2(o[4], o[5]), pack2(o[6], o[7])};
            *(u32x4*)(rowp + bj * HALF) = pk; }
          if (type == 5) {
            s1 += __shfl_xor(s1, 16); s1 += __shfl_xor(s1, 32); s2 += __shfl_xor(s2, 16); s2 += __shfl_xor(s2, 32);
            if (fq == 0) { float* vp = VST + (size_t)(((u.pn & 1) * 4 + wc) * 2) * T + r; vp[0] = s1; vp[T] = s2; } } }
    }
  }
};

struct Epi2 {
  static constexpr bool AFTER_DRAIN = true;
  const bf16_t* xb; const float* fng; float* y; float* rsp; unsigned* pc; int rowoff; const float* rinv;
  __device__ __forceinline__ void fused(f32x4 (&acc)[2][2][4][2], const Unit& u, int wr, int wc, int fr, int fq) const {
    const int row0 = rowoff + u.pm * BM + wr * 64 + fr; const int col0 = u.pn * BM + wc * 32 + 8 * fq;
    float rv[8];
#pragma unroll
    for (int it = 0; it < 8; ++it) rv[it] = rinv[row0 + (it >> 2) * HALF + (it & 3) * 16];
    u32x2 xv[2][4];
    { const bf16_t* xr = xb + (size_t)row0 * DM + col0;
#pragma unroll
      for (int q = 0; q < 4; ++q) xv[0][q] = __builtin_nontemporal_load((const u32x2*)(xr + (q >> 1) * HALF + (q & 1) * 4)); }
#pragma unroll
    for (int it = 0; it < 8; ++it) { const int ai = it >> 2, m = it & 3; const int r = row0 + ai * HALF + m * 16;
      if (it < 7) { const int r2 = row0 + ((it + 1) >> 2) * HALF + ((it + 1) & 3) * 16; const bf16_t* xr = xb + (size_t)r2 * DM + col0;
#pragma unroll
        for (int q = 0; q < 4; ++q) xv[(it + 1) & 1][q] = __builtin_nontemporal_load((const u32x2*)(xr + (q >> 1) * HALF + (q & 1) * 4)); }
      float ss = 0.f;
#pragma unroll
      for (int bj = 0; bj < 2; ++bj)
#pragma unroll
        for (int n = 0; n < 2; ++n) { const u32x2 xq = xv[it & 1][bj * 2 + n]; const f32x4 o = acc[ai][bj][m][n] + (f32x4){bf_lo(xq[0]), bf_hi(xq[0]), bf_lo(xq[1]), bf_hi(xq[1])} * rv[it]; acc[ai][bj][m][n] = o;
          ss += o[0] * o[0] + o[1] * o[1] + o[2] * o[2] + o[3] * o[3]; }
      ss += __shfl_xor(ss, 16); ss += __shfl_xor(ss, 32);
      if (fq == 0) __hip_atomic_store(rsp + (size_t)(u.pn * 4 + wc) * T + r, ss, __ATOMIC_RELAXED, __HIP_MEMORY_SCOPE_AGENT); }
    asm volatile("s_waitcnt vmcnt(0)" ::: "memory");
    __syncthreads();
    if (threadIdx.x == 0) {
      unsigned* c = pc + (size_t)(rowoff / BM + u.pm) * PC_STRIDE;
      (void)__hip_atomic_fetch_add(c, 1u, __ATOMIC_RELAXED, __HIP_MEMORY_SCOPE_AGENT);
      unsigned sp = 0u;
      while (__hip_atomic_load(c, __ATOMIC_RELAXED, __HIP_MEMORY_SCOPE_AGENT) < 4u) { __builtin_amdgcn_s_sleep(1); if (++sp > (1u << 22)) break; }
    }
    __syncthreads();
    float rs[2][4];
#pragma unroll
    for (int ai = 0; ai < 2; ++ai)
#pragma unroll
      for (int m = 0; m < 4; ++m) { const int r = row0 + ai * HALF + m * 16; float t = 0.f;
#pragma unroll
        for (int j = 0; j < 4; ++j) t += __hip_atomic_load(rsp + (size_t)(4 * fq + j) * T + r, __ATOMIC_RELAXED, __HIP_MEMORY_SCOPE_AGENT);
        t += __shfl_xor(t, 16); t += __shfl_xor(t, 32); rs[ai][m] = rsqrtf(t * (1.f / DM) + EPS); }
    f32x4 fg[2][2];
#pragma unroll
    for (int bj = 0; bj < 2; ++bj)
#pragma unroll
      for (int n = 0; n < 2; ++n) fg[bj][n] = *(const f32x4*)(fng + col0 + bj * HALF + n * 4);
#pragma unroll
    for (int ai = 0; ai < 2; ++ai)
#pragma unroll
      for (int m = 0; m < 4; ++m) { float* yr = y + (size_t)(row0 + ai * HALF + m * 16) * DM + col0;
#pragma unroll
        for (int bj = 0; bj < 2; ++bj)
#pragma unroll
          for (int n = 0; n < 2; ++n) *(f32x4*)(yr + bj * HALF + n * 4) = acc[ai][bj][m][n] * fg[bj][n] * rs[ai][m]; }
  }
};

__device__ __forceinline__ void wtiles(LAS unsigned char* lds, const Params& p, int first, int last, int start, int stride);
__device__ __forceinline__ void phase0(LAS unsigned char* lds, const Params& p) {
  const int tid = opaque_tid(), wid = tid >> 6, lane = tid & 63;
  bf16_t* XB = (bf16_t*)(p.ws + WS_XB); float* RN = (float*)(p.ws + WS_RN);
  for (int r0 = (blockIdx.x * 8 + wid) * 2; r0 < T; r0 += gridDim.x * 16) {
    f32x4 v[2][4]; float ss[2] = {0.f, 0.f};
#pragma unroll
    for (int q = 0; q < 2; ++q) { const int r = r0 + q; const float* xr = r < TP ? p.xp + (size_t)r * DM : p.xs + (size_t)(r - TP) * DM;
#pragma unroll
      for (int j = 0; j < 4; ++j) v[q][j] = __builtin_nontemporal_load((const f32x4*)(xr + j * 256 + lane * 4)); }
#pragma unroll
    for (int q = 0; q < 2; ++q) {
#pragma unroll
      for (int j = 0; j < 4; ++j) ss[q] += v[q][j][0] * v[q][j][0] + v[q][j][1] * v[q][j][1] + v[q][j][2] * v[q][j][2] + v[q][j][3] * v[q][j][3]; }
#pragma unroll
    for (int o = 32; o >= 1; o >>= 1) { ss[0] += __shfl_xor(ss[0], o); ss[1] += __shfl_xor(ss[1], o); }
    const float rq[2] = {rsqrtf(ss[0] * (1.f / DM) + EPS), rsqrtf(ss[1] * (1.f / DM) + EPS)};
    if (lane == 0) { RN[r0] = sqrtf(ss[0] * (1.f / DM) + EPS); RN[r0 + 1] = sqrtf(ss[1] * (1.f / DM) + EPS); }
#pragma unroll
    for (int q = 0; q < 2; ++q)
#pragma unroll
      for (int j = 0; j < 4; ++j) { const f32x4 w = v[q][j] * rq[q]; u32x2 pk = {pack2(w[0], w[1]), pack2(w[2], w[3])}; *(u32x2*)(XB + (size_t)(r0 + q) * DM + j * 256 + lane * 4) = pk; }
  }
  wtiles(lds, p, 0, 896, blockIdx.x, gridDim.x);
}

struct WTile { const float* src; bf16_t* dst; int ldn, kt, ntl, scol; bool fold; };
__device__ __forceinline__ WTile wtile_decode(const Params& p, int it) {
  WTile w; bf16_t* WINT = (bf16_t*)(p.ws + WS_WINT); bf16_t* WOUTT = (bf16_t*)(p.ws + WS_WOUTT);
  if (it < 896) { w.kt = it / 56; w.ntl = it % 56; w.src = p.w_in; w.ldn = DIN; w.dst = WINT; w.fold = true;
    const int n0 = w.ntl * 64;
    if (n0 < 2048) w.scol = n0;
    else if (n0 < 3072) { const int hh = (n0 - 2048) >> 8, c = (n0 - 2048) & 255; w.scol = c < 128 ? 2048 + hh * 128 + c : 3072 + hh * 128 + (c - 128); }
    else w.scol = 2560 + (n0 - 3072); }
  else { const int j = it - 896; w.kt = j / 16; w.ntl = j % 16; w.src = p.w_out; w.ldn = DM; w.dst = WOUTT; w.fold = false; w.scol = w.ntl * 64; }
  return w;
}
__device__ __forceinline__ void wtile_load(const Params& p, const WTile& w, int tid, f32x4 (&v)[2]) {
#pragma unroll
  for (int i = 0; i < 2; ++i) { const int r = (tid >> 4) + 32 * i, c4 = tid & 15;
    v[i] = __builtin_nontemporal_load((const f32x4*)(w.src + (size_t)(w.kt * 64 + r) * w.ldn + w.scol + c4 * 4)); const float g = w.fold ? p.norm_g[w.kt * 64 + r] : 1.f; v[i] = v[i] * g; }
}
__device__ __forceinline__ void wtiles(LAS unsigned char* lds, const Params& p, int first, int last, int start, int stride) {
  const int tid = opaque_tid(), wid = __builtin_amdgcn_readfirstlane(tid >> 6), lane = tid & 63;
  LAS float* tl = (LAS float*)(lds + wid * 16640);
  for (int it = first + wid * stride + start; it < last; it += stride * 8) {
    const WTile w = wtile_decode(p, it);
    f32x4 v[16];
#pragma unroll
    for (int i = 0; i < 16; ++i) { const int r = (lane >> 4) + 4 * i, c4 = lane & 15;
      v[i] = __builtin_nontemporal_load((const f32x4*)(w.src + (size_t)(w.kt * 64 + r) * w.ldn + w.scol + c4 * 4)); const float g = w.fold ? p.norm_g[w.kt * 64 + r] : 1.f; v[i] = v[i] * g; }
#pragma unroll
    for (int i = 0; i < 16; ++i) { const int r = (lane >> 4) + 4 * i, c4 = lane & 15;
#pragma unroll
      for (int j = 0; j < 4; ++j) tl[r * 65 + c4 * 4 + j] = v[i][j]; }
    asm volatile("s_waitcnt lgkmcnt(0)" ::: "memory");
#pragma unroll
    for (int i = 0; i < 8; ++i) { const int n = (lane >> 3) + 8 * i, k8 = lane & 7; float a[8];
#pragma unroll
      for (int j = 0; j < 8; ++j) a[j] = tl[(k8 * 8 + j) * 65 + n];
      const u32x4 pk = {pack2(a[0], a[1]), pack2(a[2], a[3]), pack2(a[4], a[5]), pack2(a[6], a[7])};
      *(u32x4*)(w.dst + (size_t)(w.ntl * 64 + n) * DM + w.kt * 64 + k8 * 8) = pk; }
    asm volatile("s_waitcnt lgkmcnt(0)" ::: "memory");
  }
}


__device__ __forceinline__ void tr_piece(int chunk, int lane, int& s, int& e8) { s = (chunk >> 1) * 8 + (lane >> 3); e8 = ((chunk & 1) * 8 + (lane & 7)) * 8; }
__device__ __forceinline__ void tr_write8(LAS bf16_t* Tm, int stride, int e8, int s, u32x4 v) {
  const int sp = s ^ (((e8 >> 3) & 7) << 3);
#pragma unroll
  for (int j = 0; j < 4; ++j) { Tm[(e8 + 2 * j) * stride + sp] = (bf16_t)(v[j] & 0xffffu); Tm[(e8 + 2 * j + 1) * stride + sp] = (bf16_t)(v[j] >> 16); }
}
__device__ __forceinline__ bf16x8 tr_read8(const LAS bf16_t* Tm, int stride, int e, int g0) { return *(const LAS bf16x8*)(Tm + e * stride + (g0 ^ (((e >> 3) & 7) << 3))); }

struct P2aPref { u32x2 lv[4]; u32x4 vv[2]; };
__device__ __forceinline__ void p2a_load(P2aPref& r, const Params& p, int it) {
  const int tid = opaque_tid(), wid = __builtin_amdgcn_readfirstlane(tid >> 6), lane = tid & 63;
  const int b = it >> 7, c = (it >> 2) & 31, h = it & 3, t0 = b * 2048 + c * 64;
  const float* LF = (const float*)(p.ws + WS_LF); const bf16_t* VI = (const bf16_t*)(p.ws + WS_VI);
#pragma unroll
  for (int i = 0; i < 4; ++i) { const int idx = tid + 512 * i, s = idx >> 5, c4 = idx & 31; r.lv[i] = *(const u32x2*)((const _Float16*)LF + (size_t)(t0 + s) * 512 + h * 128 + c4 * 4); }
#pragma unroll
  for (int i = 0; i < 2; ++i) { int vs, ve; tr_piece(wid + 8 * i, lane, vs, ve); r.vv[i] = *(const u32x4*)(VI + (size_t)(t0 + vs) * 512 + h * 128 + ve); }
}
__device__ __forceinline__ void p2a_item(LAS unsigned char* lds, const Params& p, int b, int c, int h, P2aPref& r, int nxt) {
  const int tid = opaque_tid(), wid = __builtin_amdgcn_readfirstlane(tid >> 6), lane = tid & 63, fr = lane & 15, fq = lane >> 4;
  LAS float* bL = (LAS float*)lds; LAS bf16_t* Vt = (LAS bf16_t*)(lds + 32768); LAS bf16_t* Kt = (LAS bf16_t*)(lds + 51200); LAS float* tot = (LAS float*)(lds + 69632);
  const float* LF = (const float*)(p.ws + WS_LF); const bf16_t* VI = (const bf16_t*)(p.ws + WS_VI); float* DEC = (float*)(p.ws + WS_DEC); bf16_t* SL = (bf16_t*)p.out;
  const int t0 = b * 2048 + c * 64, slot = (b * 4 + h) * 32 + c;
  {
#pragma unroll
    for (int i = 0; i < 4; ++i) { const int idx = tid + 512 * i, s = idx >> 5, c4 = idx & 31; *(LAS f32x4*)(bL + s * 128 + c4 * 4) = unpack4h(r.lv[i]); }
#pragma unroll
    for (int i = 0; i < 2; ++i) { int vs, ve; tr_piece(wid + 8 * i, lane, vs, ve); tr_write8(Vt, 72, ve, vs, r.vv[i]); } }
  __syncthreads();
  if (nxt < 1024) p2a_load(r, p, nxt);
  const int kk = tid & 127, jq = tid >> 7;
  float kreg[16]; float run = 0.f;
#pragma unroll
  for (int i = 0; i < 16; ++i) { const int s = 16 * jq + i; const float lf = bL[s * 128 + kk]; kreg[i] = 1.f - __builtin_amdgcn_exp2f(lf); run += lf; bL[s * 128 + kk] = run; }
  tot[jq * 128 + kk] = run;
  __syncthreads();
  float ref = 0.f, blast = 0.f;
#pragma unroll
  for (int j2 = 0; j2 < 4; ++j2) { const float tv = tot[j2 * 128 + kk]; if (j2 < jq) ref += tv; blast += tv; }
  { float kh[16];
#pragma unroll
    for (int i = 0; i < 16; ++i) { const int s = 16 * jq + i; const float bb = ref + bL[s * 128 + kk]; kh[i] = kreg[i] * __builtin_amdgcn_exp2f(blast - bb); }
    u32x4 w0 = {pack2(kh[0], kh[1]), pack2(kh[2], kh[3]), pack2(kh[4], kh[5]), pack2(kh[6], kh[7])}, w1 = {pack2(kh[8], kh[9]), pack2(kh[10], kh[11]), pack2(kh[12], kh[13]), pack2(kh[14], kh[15])};
    *(LAS u32x4*)(Kt + kk * 72 + 16 * jq) = w0; *(LAS u32x4*)(Kt + kk * 72 + 16 * jq + 8) = w1; }
  if (jq == 0) DEC[slot * 128 + kk] = __builtin_amdgcn_exp2f(blast);
  __syncthreads();
  bf16x8 A[2];
#pragma unroll
  for (int ks = 0; ks < 2; ++ks) A[ks] = *(const LAS bf16x8*)(Kt + (16 * wid + fr) * 72 + 32 * ks + 8 * fq);
#pragma unroll
  for (int nb = 0; nb < 8; ++nb) { f32x4 acc = {0.f, 0.f, 0.f, 0.f};
#pragma unroll
    for (int ks = 0; ks < 2; ++ks) { const bf16x8 B = tr_read8(Vt, 72, 16 * nb + fr, 32 * ks + 8 * fq); acc = __builtin_amdgcn_mfma_f32_16x16x32_bf16(B, A[ks], acc, 0, 0, 0); }
    u32x2 pk = {pack2(acc[0], acc[1]), pack2(acc[2], acc[3])};
    *(u32x2*)(SL + ((size_t)slot * 128 + 16 * wid + fr) * 128 + 16 * nb + 4 * fq) = pk; }
  __syncthreads();
}

__device__ __forceinline__ void p2b_item(LAS unsigned char* lds, const Params& p, int ti, int h) {
  const int tid = opaque_tid(), wid = __builtin_amdgcn_readfirstlane(tid >> 6), lane = tid & 63, fr = lane & 15, fq = lane >> 4;
  LAS bf16_t* vnt = (LAS bf16_t*)lds; LAS float* st = (LAS float*)(lds + 34816);
  const bf16_t* VG = (const bf16_t*)(p.ws + WS_VG); const bf16_t* U = (const bf16_t*)(p.ws + WS_U); const bf16_t* ZB = (const bf16_t*)(p.ws + WS_ZB); bf16_t* MIX = (bf16_t*)(p.ws + WS_MIX);
  const float* VST = (const float*)(p.ws + WS_VST);
  const int t0 = ti * 128; const bool sample = ti >= 128; const bool open = sample || ((ti & 15) == 15);
  u32x4 vg[4]; int ps[4], pe[4];
#pragma unroll
  for (int i = 0; i < 4; ++i) { tr_piece(wid + 8 * i, lane, ps[i], pe[i]); vg[i] = __builtin_nontemporal_load((const u32x4*)(VG + (size_t)(t0 + ps[i]) * 512 + h * 128 + pe[i])); }
  if (tid < 128) { float s1 = 0.f, s2 = 0.f;
#pragma unroll
    for (int j = 0; j < 8; ++j) { s1 += VST[(size_t)(2 * j) * T + t0 + tid]; s2 += VST[(size_t)(2 * j + 1) * T + t0 + tid]; }
    const float mu = s1 * (1.f / 512.f); const float var = fmaxf(s2 * (1.f / 512.f) - mu * mu, 0.f); st[2 * tid] = mu; st[2 * tid + 1] = rsqrtf(var + EPS); }
  const int t = 16 * wid + fr;
  f32x4 wv[4][2];
#pragma unroll
  for (int ks = 0; ks < 4; ++ks) { wv[ks][0] = (f32x4){0.f, 0.f, 0.f, 0.f}; wv[ks][1] = wv[ks][0];
    if (32 * ks <= 16 * wid + 15) { const int s0 = 32 * ks + 8 * fq;
      const float* wp = sample ? p.w_s + (size_t)(h * 128 + (t & 7)) * 128 : p.w_s + (size_t)(h * 128 + t) * 128 + s0;
      wv[ks][0] = *(const f32x4*)wp; wv[ks][1] = *(const f32x4*)(wp + 4); } }
  u32x2 uu[8];
#pragma unroll
  for (int nb = 0; nb < 8; ++nb) { const size_t g = (size_t)(t0 + t) * 512 + h * 128 + 16 * nb + 4 * fq; uu[nb] = __builtin_nontemporal_load((const u32x2*)(U + g)); }
  const float bias = p.b_s[h * 128 + (sample ? (t & 7) : t)];
  __syncthreads();
  float* vout = p.out + (sample ? O_VS + (size_t)(t0 - TP) * 512 : O_VP + (size_t)(ti >> 4) * 128 * 512);
#pragma unroll
  for (int i = 0; i < 4; ++i) { const int s = ps[i], e8 = pe[i]; float a[8]; unpack8(vg[i], a);
    const float mu = st[2 * s], rs = st[2 * s + 1]; const f32x4 g0 = *(const f32x4*)(p.lng + h * 128 + e8), g1 = *(const f32x4*)(p.lng + h * 128 + e8 + 4), b0 = *(const f32x4*)(p.lnb + h * 128 + e8), b1 = *(const f32x4*)(p.lnb + h * 128 + e8 + 4);
    float vn[8];
#pragma unroll
    for (int j = 0; j < 4; ++j) { vn[j] = (a[j] - mu) * rs * g0[j] + b0[j]; vn[4 + j] = (a[4 + j] - mu) * rs * g1[j] + b1[j]; }
    const u32x4 pk = {pack2(vn[0], vn[1]), pack2(vn[2], vn[3]), pack2(vn[4], vn[5]), pack2(vn[6], vn[7])};
    tr_write8(vnt, 136, e8, s, pk);
    if (open) { float* o = vout + (size_t)s * 512 + h * 128 + e8; *(f32x4*)o = (f32x4){vn[0], vn[1], vn[2], vn[3]}; *(f32x4*)(o + 4) = (f32x4){vn[4], vn[5], vn[6], vn[7]}; } }
  __syncthreads();
  bf16x8 A[4];
#pragma unroll
  for (int ks = 0; ks < 4; ++ks) { const int s0 = 32 * ks + 8 * fq; float a[8];
#pragma unroll
    for (int j = 0; j < 4; ++j) { a[j] = wv[ks][0][j]; a[4 + j] = wv[ks][1][j]; }
    if (sample) { const bool vb = (s0 >> 3) == (t >> 3);
#pragma unroll
      for (int j = 0; j < 8; ++j) a[j] = (vb && j <= (t & 7)) ? a[j] : 0.f; }
    else {
#pragma unroll
      for (int j = 0; j < 8; ++j) a[j] = (s0 + j <= t) ? a[j] : 0.f; }
    A[ks] = pack8(a); }
#pragma unroll
  for (int nb = 0; nb < 8; ++nb) { f32x4 acc = {0.f, 0.f, 0.f, 0.f};
#pragma unroll
    for (int ks = 0; ks < 4; ++ks) if (32 * ks <= 16 * wid + 15) { const bf16x8 B = tr_read8(vnt, 136, 16 * nb + fr, 32 * ks + 8 * fq); acc = __builtin_amdgcn_mfma_f32_16x16x32_bf16(B, A[ks], acc, 0, 0, 0); }
    const int e = 16 * nb + 4 * fq;
    const float o0 = (acc[0] + bias) * bf_lo(uu[nb][0]), o1 = (acc[1] + bias) * bf_hi(uu[nb][0]);
    const float o2 = (acc[2] + bias) * bf_lo(uu[nb][1]), o3 = (acc[3] + bias) * bf_hi(uu[nb][1]);
    u32x2 pk = {pack2(o0, o1), pack2(o2, o3)};
    *(u32x2*)(MIX + (size_t)(t0 + t) * DM + 512 + h * 128 + e) = pk; }
  __syncthreads();
}

struct P2bPref { u32x4 vg[4]; u32x2 uu[8]; float s1, s2; };
__device__ __forceinline__ void p2b_load(P2bPref& r, const Params& p, int it, int h, int tid, int wid, int lane, int t, int fq) {
  const bf16_t* VG = (const bf16_t*)(p.ws + WS_VG); const bf16_t* U = (const bf16_t*)(p.ws + WS_U); const float* VST = (const float*)(p.ws + WS_VST);
  const int t0 = (it >> 2) * 128;
#pragma unroll
  for (int i = 0; i < 4; ++i) { int ps, pe; tr_piece(wid + 8 * i, lane, ps, pe); r.vg[i] = __builtin_nontemporal_load((const u32x4*)(VG + (size_t)(t0 + ps) * 512 + h * 128 + pe)); }
#pragma unroll
  for (int nb = 0; nb < 8; ++nb) r.uu[nb] = __builtin_nontemporal_load((const u32x2*)(U + (size_t)(t0 + t) * 512 + h * 128 + 16 * nb + 4 * fq));
  r.s1 = 0.f; r.s2 = 0.f;
  if (tid < 128) {
#pragma unroll
    for (int j = 0; j < 8; ++j) { r.s1 += VST[(size_t)(2 * j) * T + t0 + tid]; r.s2 += VST[(size_t)(2 * j + 1) * T + t0 + tid]; } }
}
__device__ __forceinline__ void p2b_run(LAS unsigned char* lds, const Params& p, int it0, int stride, int nmax) {
  if (it0 >= nmax) return;
  const int tid = opaque_tid(), wid = __builtin_amdgcn_readfirstlane(tid >> 6), lane = tid & 63, fr = lane & 15, fq = lane >> 4;
  LAS bf16_t* vnt = (LAS bf16_t*)lds; LAS float* st = (LAS float*)(lds + 34816);
  bf16_t* MIX = (bf16_t*)(p.ws + WS_MIX);
  const int h = it0 & 3, t = 16 * wid + fr;
  P2bPref r; p2b_load(r, p, it0, h, tid, wid, lane, t, fq);
  bf16x8 A[4];
#pragma unroll
  for (int ks = 0; ks < 4; ++ks) { float a[8];
#pragma unroll
    for (int j = 0; j < 8; ++j) a[j] = 0.f;
    if (32 * ks <= 16 * wid + 15) { const int s0 = 32 * ks + 8 * fq; const float* wp = p.w_s + (size_t)(h * 128 + t) * 128 + s0;
      const f32x4 w0 = *(const f32x4*)wp, w1 = *(const f32x4*)(wp + 4);
#pragma unroll
      for (int j = 0; j < 4; ++j) { a[j] = (s0 + j <= t) ? w0[j] : 0.f; a[4 + j] = (s0 + 4 + j <= t) ? w1[j] : 0.f; } }
    A[ks] = pack8(a); }
  const float bias = p.b_s[h * 128 + t];
  int e8c; { int ps0; tr_piece(wid, lane, ps0, e8c); }
  const f32x4 g0 = *(const f32x4*)(p.lng + h * 128 + e8c), g1 = *(const f32x4*)(p.lng + h * 128 + e8c + 4), b0 = *(const f32x4*)(p.lnb + h * 128 + e8c), b1 = *(const f32x4*)(p.lnb + h * 128 + e8c + 4);
  for (int it = it0; it < nmax; it += stride) {
    const int ti = it >> 2, t0 = ti * 128; const bool open = (ti & 15) == 15;
    if (tid < 128) { const float mu = r.s1 * (1.f / 512.f); const float var = fmaxf(r.s2 * (1.f / 512.f) - mu * mu, 0.f); st[2 * tid] = mu; st[2 * tid + 1] = rsqrtf(var + EPS); }
    u32x4 cvg[4]; u32x2 cuu[8];
#pragma unroll
    for (int i = 0; i < 4; ++i) cvg[i] = r.vg[i];
#pragma unroll
    for (int nb = 0; nb < 8; ++nb) cuu[nb] = r.uu[nb];
    __syncthreads();
    if (it + stride < nmax) p2b_load(r, p, it + stride, h, tid, wid, lane, t, fq);
    float* vout = p.out + O_VP + (size_t)(ti >> 4) * 128 * 512;
#pragma unroll
    for (int i = 0; i < 4; ++i) { int s, e8; tr_piece(wid + 8 * i, lane, s, e8); float a[8]; unpack8(cvg[i], a);
      const float mu = st[2 * s], rs = st[2 * s + 1]; float vn[8];
#pragma unroll
      for (int j = 0; j < 4; ++j) { vn[j] = (a[j] - mu) * rs * g0[j] + b0[j]; vn[4 + j] = (a[4 + j] - mu) * rs * g1[j] + b1[j]; }
      const u32x4 pk = {pack2(vn[0], vn[1]), pack2(vn[2], vn[3]), pack2(vn[4], vn[5]), pack2(vn[6], vn[7])};
      tr_write8(vnt, 136, e8, s, pk);
      if (open) { float* o = vout + (size_t)s * 512 + h * 128 + e8; *(f32x4*)o = (f32x4){vn[0], vn[1], vn[2], vn[3]}; *(f32x4*)(o + 4) = (f32x4){vn[4], vn[5], vn[6], vn[7]}; } }
    __syncthreads();
#pragma unroll
    for (int nb = 0; nb < 8; ++nb) { f32x4 acc = {0.f, 0.f, 0.f, 0.f};
#pragma unroll
      for (int ks = 0; ks < 4; ++ks) if (32 * ks <= 16 * wid + 15) { const bf16x8 B = tr_read8(vnt, 136, 16 * nb + fr, 32 * ks + 8 * fq); acc = __builtin_amdgcn_mfma_f32_16x16x32_bf16(B, A[ks], acc, 0, 0, 0); }
      const int e = 16 * nb + 4 * fq;
      const float o0 = (acc[0] + bias) * bf_lo(cuu[nb][0]), o1 = (acc[1] + bias) * bf_hi(cuu[nb][0]);
      const float o2 = (acc[2] + bias) * bf_lo(cuu[nb][1]), o3 = (acc[3] + bias) * bf_hi(cuu[nb][1]);
      const unsigned long long pk = (unsigned long long)pack2(o0, o1) | ((unsigned long long)pack2(o2, o3) << 32);
      __hip_atomic_store((unsigned long long*)(MIX + (size_t)(t0 + t) * DM + 512 + h * 128 + e), pk, __ATOMIC_RELAXED, __HIP_MEMORY_SCOPE_AGENT); }
    asm volatile("s_waitcnt vmcnt(0)" ::: "memory");
    __syncthreads();
    if (tid == 0) (void)__hip_atomic_fetch_add((unsigned*)(p.ws + WS_BAR) + RDY_OFF + (size_t)(ti >> 1) * RDY_STRIDE, 1u, __ATOMIC_RELAXED, __HIP_MEMORY_SCOPE_AGENT);
  }
}

__device__ __forceinline__ void p2c_item(LAS unsigned char* lds, const Params& p, int n, int h) {
  const int tid = opaque_tid(), wid = tid >> 6, lane = tid & 63;
  LAS float* qs = (LAS float*)lds; LAS float* fs = qs + 1024; LAS float* ks_ = qs + 2048; LAS float* vs = qs + 3072; LAS float* opart = qs + 4096;
  const float* LF = (const float*)(p.ws + WS_LF); const bf16_t* Q = (const bf16_t*)(p.ws + WS_Q); const bf16_t* VI = (const bf16_t*)(p.ws + WS_VI); const bf16_t* ZA = (const bf16_t*)(p.ws + WS_ZA); bf16_t* MIX = (bf16_t*)(p.ws + WS_MIX);
  const int t0 = TP + n * 8;
#pragma unroll
  for (int i = 0; i < 2; ++i) { const int idx = tid + 512 * i, t = idx >> 7, kk = idx & 127; const size_t g = (size_t)(t0 + t) * 512 + h * 128 + kk;
    const float f = __builtin_amdgcn_exp2f((float)((const _Float16*)LF)[g]); fs[idx] = f; ks_[idx] = 1.f - f; qs[idx] = bf2f(Q[g]); vs[idx] = bf2f(VI[g]); }
  const int e = tid & 127, kq = __builtin_amdgcn_readfirstlane(tid >> 7);
  const size_t sbase = ((size_t)(n * 4 + h) * 128 + kq * 32) * 128 + e;
  float S[32];
#pragma unroll
  for (int i = 0; i < 32; ++i) S[i] = __builtin_nontemporal_load(p.st0 + sbase + (size_t)i * 128);
  __syncthreads();
#pragma unroll 1
  for (int t = 0; t < 8; ++t) { const float v = vs[t * 128 + e]; float po = 0.f;
#pragma unroll
    for (int i = 0; i < 32; ++i) { const int kk = kq * 32 + i; S[i] = fs[t * 128 + kk] * S[i] + ks_[t * 128 + kk] * v; po += qs[t * 128 + kk] * S[i]; }
    opart[(kq * 8 + t) * 128 + e] = po; }
  float* so = p.out + O_SS;
#pragma unroll
  for (int i = 0; i < 32; ++i) so[sbase + (size_t)i * 128] = S[i];
  __syncthreads();
  { const int t = wid; float o[2]; float ss = 0.f;
#pragma unroll
    for (int hf = 0; hf < 2; ++hf) { const int ee = lane + 64 * hf; o[hf] = opart[(0 * 8 + t) * 128 + ee] + opart[(1 * 8 + t) * 128 + ee] + opart[(2 * 8 + t) * 128 + ee] + opart[(3 * 8 + t) * 128 + ee]; ss += o[hf] * o[hf]; }
#pragma unroll
    for (int of = 32; of >= 1; of >>= 1) ss += __shfl_xor(ss, of);
    const float rs = rsqrtf(ss * (1.f / 128.f) + EPS);
#pragma unroll
    for (int hf = 0; hf < 2; ++hf) { const int ee = lane + 64 * hf; MIX[(size_t)(t0 + t) * DM + h * 128 + ee] = f2bf(o[hf] * rs * p.hgn[h * 128 + ee] * bf2f(ZA[(size_t)(t0 + t) * 512 + h * 128 + ee])); } }
  __syncthreads();
}

__device__ __forceinline__ void scan_phase(const Params& p, int blk, int nblk) {
  const float* __restrict__ DEC = (const float*)(p.ws + WS_DEC); const bf16_t* __restrict__ SL = (const bf16_t*)p.out; bf16_t* __restrict__ SST = (bf16_t*)(p.ws + WS_SST); float* __restrict__ sp = p.out + O_SP;
  const int ntrip = (nblk * 512 >= 131072) ? 1 : ((blk >= 48 && blk < 48 + (131072 - nblk * 512 + 511) / 512) ? 2 : 1);
  for (int trip = 0; trip < ntrip; ++trip) { const int idx = trip == 0 ? blk * 512 + opaque_tid() : nblk * 512 + (blk - 48) * 512 + opaque_tid(); if (idx >= 131072) continue;
    const int bh = idx >> 12, r = idx & 4095, kk = r >> 5, e4 = (r & 31) * 4;
    const size_t off0 = ((size_t)(bh * 32) * 128 + kk) * 128 + e4;
    const float* dp = DEC + (size_t)bh * 32 * 128 + kk;
    f32x4 S = {0.f, 0.f, 0.f, 0.f};
    u32x2 sl[2][8]; float d[2][8];
#pragma unroll
    for (int j = 0; j < 8; ++j) { sl[0][j] = __builtin_nontemporal_load((const u32x2*)(SL + off0 + (size_t)j * 16384)); d[0][j] = dp[j * 128]; }
#pragma unroll
    for (int k = 0; k < 4; ++k) {
      if (k < 3) {
#pragma unroll
        for (int j = 0; j < 8; ++j) { const int c = 8 * (k + 1) + j; sl[(k + 1) & 1][j] = __builtin_nontemporal_load((const u32x2*)(SL + off0 + (size_t)c * 16384)); d[(k + 1) & 1][j] = dp[c * 128]; }
      }
#pragma unroll
      for (int j = 0; j < 8; ++j) { const int c = 8 * k + j;
        __hip_atomic_store((unsigned long long*)(SST + off0 + (size_t)c * 16384), (unsigned long long)pack2(S[0], S[1]) | ((unsigned long long)pack2(S[2], S[3]) << 32), __ATOMIC_RELAXED, __HIP_MEMORY_SCOPE_AGENT);
        const u32x2 q = sl[k & 1][j]; const f32x4 slv = {bf_lo(q[0]), bf_hi(q[0]), bf_lo(q[1]), bf_hi(q[1])};
        S = S * d[k & 1][j] + slv; }
    }
    *(f32x4*)(sp + ((size_t)bh * 128 + kk) * 128 + e4) = S;
    asm volatile("s_waitcnt vmcnt(0)" ::: "memory");
    __syncthreads();
    if (threadIdx.x == 0) (void)__hip_atomic_fetch_add((unsigned*)(p.ws + WS_BAR) + SCN_OFF + (size_t)bh * SCN_STRIDE, 1u, __ATOMIC_RELAXED, __HIP_MEMORY_SCOPE_AGENT);
  }
}
__device__ __forceinline__ void p4_wait(const Params& p, int it) {
  if (threadIdx.x == 0) { const unsigned* c = (const unsigned*)(p.ws + WS_BAR) + SCN_OFF + (size_t)((it >> 7) * 4 + (it & 3)) * SCN_STRIDE; unsigned sp_ = 0u;
    while (__hip_atomic_load(c, __ATOMIC_RELAXED, __HIP_MEMORY_SCOPE_AGENT) < 8u) { __builtin_amdgcn_s_sleep(2); if (++sp_ > (1u << 21)) break; }
    __builtin_amdgcn_fence(__ATOMIC_ACQUIRE, "agent");
    asm volatile("s_waitcnt vmcnt(0)" ::: "memory"); }
}

struct P4Pref { u32x2 lv[4]; u32x4 vv[2], qq[2], sv[4]; };
__device__ __forceinline__ void p4_load(P4Pref& r, const Params& p, int it) {
  const int tid = opaque_tid(), wid = __builtin_amdgcn_readfirstlane(tid >> 6), lane = tid & 63;
  const int b = it >> 7, c = (it >> 2) & 31, h = it & 3, t0 = b * 2048 + c * 64, slot = (b * 4 + h) * 32 + c;
  const float* LF = (const float*)(p.ws + WS_LF); const bf16_t* VI = (const bf16_t*)(p.ws + WS_VI); const bf16_t* Q = (const bf16_t*)(p.ws + WS_Q); const bf16_t* SST = (const bf16_t*)(p.ws + WS_SST);
#pragma unroll
  for (int i = 0; i < 4; ++i) { const int idx = tid + 512 * i, s = idx >> 5, c4 = idx & 31; r.lv[i] = __builtin_nontemporal_load((const u32x2*)((const _Float16*)LF + (size_t)(t0 + s) * 512 + h * 128 + c4 * 4)); }
#pragma unroll
  for (int i = 0; i < 2; ++i) { int vs, ve; tr_piece(wid + 8 * i, lane, vs, ve); const size_t g = (size_t)(t0 + vs) * 512 + h * 128 + ve; r.vv[i] = __builtin_nontemporal_load((const u32x4*)(VI + g)); r.qq[i] = __builtin_nontemporal_load((const u32x4*)(Q + g)); }
#pragma unroll
  for (int i = 0; i < 4; ++i) { int sk, se; tr_piece(wid + 8 * i, lane, sk, se); r.sv[i] = __builtin_nontemporal_load((const u32x4*)(SST + ((size_t)slot * 128 + sk) * 128 + se)); }
}
__device__ __forceinline__ void p4_item(LAS unsigned char* lds, const Params& p, int b, int c, int h, P4Pref& r, int nxt) {
  const int tid = opaque_tid(), wid = __builtin_amdgcn_readfirstlane(tid >> 6), lane = tid & 63, fr = lane & 15, fq = lane >> 4;
  LAS float* bL = (LAS float*)lds; LAS bf16_t* Vt = (LAS bf16_t*)(lds + 33792); LAS bf16_t* Kb = (LAS bf16_t*)(lds + 52224); LAS bf16_t* Qb = (LAS bf16_t*)(lds + 69632);
  LAS bf16_t* P = (LAS bf16_t*)(lds + 87040); LAS float* tot = (LAS float*)(lds + 96256); LAS bf16_t* StT = (LAS bf16_t*)(lds + 98304); LAS float* ssq = (LAS float*)(lds + 133120);
  const float* LF = (const float*)(p.ws + WS_LF); const bf16_t* VI = (const bf16_t*)(p.ws + WS_VI); const bf16_t* Q = (const bf16_t*)(p.ws + WS_Q); const bf16_t* ZA = (const bf16_t*)(p.ws + WS_ZA);
  const bf16_t* SST = (const bf16_t*)(p.ws + WS_SST); bf16_t* MIX = (bf16_t*)(p.ws + WS_MIX);
  const int t0 = b * 2048 + c * 64, slot = (b * 4 + h) * 32 + c;
  const int mb = wid & 3, nb0 = (wid >> 2) * 4; const int t = 16 * mb + fr;
  u32x2 zq[4]; f32x4 hq[4];
#pragma unroll
  for (int nbi = 0; nbi < 4; ++nbi) { const int e = 16 * (nb0 + nbi) + 4 * fq; hq[nbi] = *(const f32x4*)(p.hgn + h * 128 + e); zq[nbi] = __builtin_nontemporal_load((const u32x2*)(ZA + (size_t)(t0 + t) * 512 + h * 128 + e)); }
#pragma unroll
  for (int i = 0; i < 4; ++i) { const int idx = tid + 512 * i, s = idx >> 5, c4 = idx & 31; *(LAS f32x4*)(bL + s * 132 + c4 * 4) = unpack4h(r.lv[i]); }
#pragma unroll
  for (int i = 0; i < 2; ++i) { int vs, ve; tr_piece(wid + 8 * i, lane, vs, ve); tr_write8(Vt, 72, ve, vs, r.vv[i]); *(LAS u32x4*)(Qb + vs * 136 + ve) = r.qq[i]; }
#pragma unroll
  for (int i = 0; i < 4; ++i) { int sk, se; tr_piece(wid + 8 * i, lane, sk, se); tr_write8(StT, 136, se, sk, r.sv[i]); }
  for (int i = tid; i < 576; i += 512) *(LAS u32x4*)(P + i * 8) = (u32x4){0u, 0u, 0u, 0u};
  if (nxt < 1024) p4_wait(p, nxt);
  __syncthreads();
  if (nxt < 1024) p4_load(r, p, nxt);
  { const int kk = tid & 127, jq = tid >> 7; float run = 0.f;
#pragma unroll
    for (int i = 0; i < 16; ++i) { const int s = 16 * jq + i; const float lf = bL[s * 132 + kk]; const float kv = 1.f - __builtin_amdgcn_exp2f(lf); run += lf;
      const float qv = bf2f(Qb[s * 136 + kk]); Qb[s * 136 + kk] = f2bf(qv * __builtin_amdgcn_exp2f(run)); Kb[s * 136 + kk] = f2bf(kv * __builtin_amdgcn_exp2f(-run)); }
    tot[jq * 128 + kk] = run; }
  __syncthreads();
  { const int ntask = wid < 6 ? 1 : 2;
    for (int q2 = 0; q2 < ntask; ++q2) {
      int I, J;
      if (wid < 6) { I = wid >= 3 ? 3 : wid >= 1 ? 2 : 1; J = wid - (wid >= 3 ? 3 : wid >= 1 ? 1 : 0); }
      else { I = (wid - 6) * 2 + q2; J = I; }
      f32x4 acc = {0.f, 0.f, 0.f, 0.f};
#pragma unroll
      for (int ks = 0; ks < 4; ++ks) { const int kk0 = 32 * ks + 8 * fq;
        const bf16x8 A = *(const LAS bf16x8*)(Qb + (16 * I + fr) * 136 + kk0);
        bf16x8 B = *(const LAS bf16x8*)(Kb + (16 * J + fr) * 136 + kk0);
        if (J < I) { float kv[8], bb[8]; unpack8(__builtin_bit_cast(u32x4, B), kv);
          f32x4 d0 = {0.f, 0.f, 0.f, 0.f}, d1 = {0.f, 0.f, 0.f, 0.f};
          for (int j2 = J; j2 < I; ++j2) { d0 += *(const LAS f32x4*)(tot + j2 * 128 + kk0); d1 += *(const LAS f32x4*)(tot + j2 * 128 + kk0 + 4); }
#pragma unroll
          for (int j = 0; j < 4; ++j) { bb[j] = kv[j] * __builtin_amdgcn_exp2f(d0[j]); bb[4 + j] = kv[4 + j] * __builtin_amdgcn_exp2f(d1[j]); }
          B = pack8(bb); }
        acc = __builtin_amdgcn_mfma_f32_16x16x32_bf16(A, B, acc, 0, 0, 0); }
#pragma unroll
      for (int rg = 0; rg < 4; ++rg) { const int tl = 4 * fq + rg; const float v = (J == I && fr > tl) ? 0.f : acc[rg]; P[(16 * I + tl) * 72 + 16 * J + fr] = f2bf(v); }
    } }
  __syncthreads();
  bf16x8 AP[2], AQ[4];
#pragma unroll
  for (int ks = 0; ks < 2; ++ks) AP[ks] = *(const LAS bf16x8*)(P + t * 72 + 32 * ks + 8 * fq);
#pragma unroll
  for (int ks = 0; ks < 4; ++ks) { const int kk0 = 32 * ks + 8 * fq; float qv[8], a[8]; unpack8(*(const LAS u32x4*)(Qb + t * 136 + kk0), qv);
    f32x4 b0 = {0.f, 0.f, 0.f, 0.f}, b1 = {0.f, 0.f, 0.f, 0.f};
    for (int j2 = 0; j2 < mb; ++j2) { b0 += *(const LAS f32x4*)(tot + j2 * 128 + kk0); b1 += *(const LAS f32x4*)(tot + j2 * 128 + kk0 + 4); }
#pragma unroll
    for (int j = 0; j < 4; ++j) { a[j] = qv[j] * __builtin_amdgcn_exp2f(b0[j]); a[4 + j] = qv[4 + j] * __builtin_amdgcn_exp2f(b1[j]); }
    AQ[ks] = pack8(a); }
  f32x4 o[4]; float ss = 0.f;
#pragma unroll
  for (int nbi = 0; nbi < 4; ++nbi) { const int nb = nb0 + nbi; f32x4 acc = {0.f, 0.f, 0.f, 0.f};
#pragma unroll
    for (int ks = 0; ks < 2; ++ks) { const bf16x8 B = tr_read8(Vt, 72, 16 * nb + fr, 32 * ks + 8 * fq); acc = __builtin_amdgcn_mfma_f32_16x16x32_bf16(B, AP[ks], acc, 0, 0, 0); }
#pragma unroll
    for (int ks = 0; ks < 4; ++ks) { const bf16x8 B = tr_read8(StT, 136, 16 * nb + fr, 32 * ks + 8 * fq); acc = __builtin_amdgcn_mfma_f32_16x16x32_bf16(B, AQ[ks], acc, 0, 0, 0); }
    o[nbi] = acc; ss += acc[0] * acc[0] + acc[1] * acc[1] + acc[2] * acc[2] + acc[3] * acc[3]; }
  ss += __shfl_xor(ss, 16); ss += __shfl_xor(ss, 32);
  if (fq == 0) ssq[(wid >> 2) * 64 + t] = ss;
  __syncthreads();
  const float rs = rsqrtf((ssq[t] + ssq[64 + t]) * (1.f / 128.f) + EPS);
#pragma unroll
  for (int nbi = 0; nbi < 4; ++nbi) { const int e = 16 * (nb0 + nbi) + 4 * fq; const f32x4 hg = hq[nbi];
    const u32x2 zz = zq[nbi];
    const float o0 = o[nbi][0] * rs * hg[0] * bf_lo(zz[0]), o1 = o[nbi][1] * rs * hg[1] * bf_hi(zz[0]), o2 = o[nbi][2] * rs * hg[2] * bf_lo(zz[1]), o3 = o[nbi][3] * rs * hg[3] * bf_hi(zz[1]);
    const unsigned long long pk = (unsigned long long)pack2(o0, o1) | ((unsigned long long)pack2(o2, o3) << 32);
    __hip_atomic_store((unsigned long long*)(MIX + (size_t)(t0 + t) * DM + h * 128 + e), pk, __ATOMIC_RELAXED, __HIP_MEMORY_SCOPE_AGENT); }
  asm volatile("s_waitcnt vmcnt(0)" ::: "memory");
  __syncthreads();
  if (tid == 0) (void)__hip_atomic_fetch_add((unsigned*)(p.ws + WS_BAR) + RDY_OFF + (size_t)(t0 >> 8) * RDY_STRIDE, 1u, __ATOMIC_RELAXED, __HIP_MEMORY_SCOPE_AGENT);
}

__device__ __forceinline__ void phase6(const Params& p) {
  const int tid = opaque_tid(), wid = tid >> 6, lane = tid & 63;
  const float* RSP = (const float*)(p.ws + WS_RSP); float* y = p.out + O_Y;
  for (int r = blockIdx.x * 8 + wid; r < T; r += gridDim.x * 8) {
    float ss = RSP[(size_t)(lane & 15) * T + r];
#pragma unroll
    for (int o = 8; o >= 1; o >>= 1) ss += __shfl_xor(ss, o);
    const float rs = rsqrtf(ss * (1.f / DM) + EPS);
#pragma unroll
    for (int j = 0; j < 4; ++j) { float* yp = y + (size_t)r * DM + j * 256 + lane * 4; const f32x4 g = *(const f32x4*)(p.fng + j * 256 + lane * 4); f32x4 v = *(const f32x4*)yp; v = v * g * rs; *(f32x4*)yp = v; }
  }
}

__global__ void __launch_bounds__(512, 2) fwd_mega(Params p) {
  cg::grid_group grid = cg::this_grid();
  extern __shared__ __attribute__((aligned(16))) unsigned char shm[];
  LAS unsigned char* lds = (LAS unsigned char*)shm;
  const int G = (int)gridDim.x, blk = (int)blockIdx.x;
  volatile LAS unsigned* xst = (volatile LAS unsigned*)(lds + LDS_ST_OFF);
  if (threadIdx.x == 0) { xst[0] = 0u; xst[1] = 0u; xst[2] = 0u; xst[3] = 0u; }
  __syncthreads();
  const XcdBarrier xb = xcd_barrier_post((unsigned*)(p.ws + WS_BAR), xst);
#define GRID_SYNC() do { if (p.use_cg) grid.sync(); else xcd_barrier(xb); } while (0)

  for (int rep = 0; rep < R0; ++rep) phase0(lds, p);
  GRID_SYNC();

  { Gemm g{(const bf16_t*)(p.ws + WS_XB), (const bf16_t*)(p.ws + WS_WINT), T, DIN, DM}; StaticOrder S; S.init(T, DIN, G, blk);
    Epi1 E{(const float*)(p.ws + WS_RN), p.lbl, (bf16_t*)(p.ws + WS_Q), (bf16_t*)(p.ws + WS_VI), (bf16_t*)(p.ws + WS_ZA), (bf16_t*)(p.ws + WS_U), (bf16_t*)(p.ws + WS_VG), (bf16_t*)(p.ws + WS_ZB), (float*)(p.ws + WS_LF), (float*)(p.ws + WS_VST)};
    gemm_phase(lds, g, S, E); }
  { const int nfull = (T / BM) * (DIN / BM) - 3 * G;
    if (blk >= nfull && nfull > 0 && nfull < G) { const int j = blk - nfull, nj = G - nfull;
      wtiles(lds, p, 896, 896 + 256, j, nj);
      float acc_ = 0.f;
      for (size_t l = (size_t)j * 512 + opaque_tid(); l < (size_t)128 * 4 * 16384 / 32 / 2; l += (size_t)nj * 512) acc_ += p.st0[l * 32];
      if (acc_ == 12345.678f) ((float*)(p.ws + WS_RN))[0] = acc_; } }
  GRID_SYNC();

  {
    const bool giver = (blk >= 32 && blk < 64) && G == 256, taker = G == 256 && blk >= 64 && ((blk - 64) % 6 == 0) && ((blk - 64) / 6 < 32);
    const int nit = G == 256 ? (giver ? 3 : (taker ? 5 : 4)) : (1024 - blk + G - 1) / G;
    P2aPref r; if (nit > 0) p2a_load(r, p, blk);
    for (int k = 0; k < nit; ++k) { const int id = k < 4 || G != 256 ? blk + G * k : 32 + (blk - 64) / 6 + 768;
      const int k1 = k + 1; const int nx = k1 < nit ? ((k1 < 4 || G != 256) ? blk + G * k1 : 32 + (blk - 64) / 6 + 768) : 1024;
      p2a_item(lds, p, id >> 7, (id >> 2) & 31, id & 3, r, nx); } }
  if (blk < 32) { p2b_item(lds, p, 128 + (blk >> 2), blk & 3); p2c_item(lds, p, blk >> 2, blk & 3); }
  else { for (int j = blk; j < 512; j += G - 32) p2c_item(lds, p, j >> 2, j & 3); }
  GRID_SYNC();

  if (blk < NG2) {
    Gemm g{(const bf16_t*)(p.ws + WS_MIX) + (size_t)TP * DM, (const bf16_t*)(p.ws + WS_WOUTT), T - TP, DM, DM}; StaticOrder S; S.init(T - TP, DM, NG2, blk);
    Epi2 E{(const bf16_t*)(p.ws + WS_XB), p.fng, p.out + O_Y, (float*)(p.ws + WS_RSP), (unsigned*)(p.ws + WS_BAR) + XCD_BAR_WORDS_C, TP, (const float*)(p.ws + WS_RN)};
    gemm_phase(lds, g, S, E);
  } else {
    for (int rep = 0; rep < R3; ++rep) scan_phase(p, blk - NG2, G - NG2);
    p2b_run(lds, p, blk - NG2, G - NG2, 512);
  }
  { P4Pref r; int i4 = blk; if (i4 < 1024) { p4_wait(p, i4); __syncthreads(); p4_load(r, p, i4); }
    for (; i4 < 1024; i4 += G) p4_item(lds, p, i4 >> 7, (i4 >> 2) & 31, i4 & 3, r, i4 + G); }
  {
    StaticOrder S; S.init(TP, DM, G, blk); Unit u;
    if (S.next(0, u)) { float acc_ = 0.f;
#pragma unroll
      for (int i = 0; i < 2; ++i) { const int l = opaque_tid() + 512 * i; acc_ += (float)((const bf16_t*)(p.ws + WS_XB))[(size_t)(u.pm * BM + (l >> 2)) * DM + u.pn * BM + (l & 3) * 64]; }
      if (acc_ == 12345.678f) ((float*)(p.ws + WS_RN))[0] = acc_; } }

  { Gemm g{(const bf16_t*)(p.ws + WS_MIX), (const bf16_t*)(p.ws + WS_WOUTT), TP, DM, DM}; StaticOrder S; S.init(TP, DM, G, blk);
    Epi2 E{(const bf16_t*)(p.ws + WS_XB), p.fng, p.out + O_Y, (float*)(p.ws + WS_RSP), (unsigned*)(p.ws + WS_BAR) + XCD_BAR_WORDS_C, 0, (const float*)(p.ws + WS_RN)};
    gemm_phase(lds, g, S, E, (const unsigned*)(p.ws + WS_BAR) + RDY_OFF, 24u); }
}

extern "C" void kernel_launch(void* const* d_in, const int* in_sizes, int n_in, void* d_out, int out_size,
                              void* d_ws, size_t ws_size, hipStream_t stream) {
  static int grid_blocks = 0;
  if (!grid_blocks) {
    int dev = 0, cus = 0, per_cu = 0;
    (void)hipGetDevice(&dev);
    (void)hipDeviceGetAttribute(&cus, hipDeviceAttributeMultiprocessorCount, dev);
    (void)hipFuncSetAttribute((const void*)fwd_mega, hipFuncAttributeMaxDynamicSharedMemorySize, LDS_BYTES);
    (void)hipOccupancyMaxActiveBlocksPerMultiprocessor(&per_cu, (const void*)fwd_mega, 512, LDS_BYTES);
    if (cus < 32) cus = 256;
    grid_blocks = 256;
    if (ws_size < WS_END) fprintf(stderr, "kernel_launch: workspace too small (%zu < %zu)\n", ws_size, (size_t)WS_END);
  }
  Params p{};
  p.xp = (const float*)d_in[0]; p.xs = (const float*)d_in[1]; p.st0 = (const float*)d_in[2]; p.norm_g = (const float*)d_in[3]; p.w_in = (const float*)d_in[4];
  p.lbl = (const float*)d_in[5]; p.hgn = (const float*)d_in[6]; p.lng = (const float*)d_in[7]; p.lnb = (const float*)d_in[8]; p.w_s = (const float*)d_in[9];
  p.b_s = (const float*)d_in[10]; p.w_out = (const float*)d_in[11]; p.fng = (const float*)d_in[12];
  p.out = (float*)d_out; p.ws = (unsigned char*)d_ws;
  p.use_cg = 0; p.pad = 0;
  (void)hipMemsetAsync((unsigned char*)d_ws + WS_BAR, 0, BAR_BYTES, stream);
  void* args[] = {&p};
  hipError_t e = hipLaunchCooperativeKernel((const void*)fwd_mega, dim3(grid_blocks), dim3(512), args, LDS_BYTES, stream);
  if (e != hipSuccess) fprintf(stderr, "cooperative launch failed: %s (grid %d)\n", hipGetErrorString(e), grid_blocks);
}
```
